# Optimizing an MI355X kernel written in HIP

```python
import jax, jax.numpy as jnp
from jax import lax
import numpy as np

D_MODEL = 1024
BATCH = 4
SEQ = 4096
DEPTH = 1
DEC_BATCH = 16
DEC_SEQ = 2048
PAST_LEN = 128

HEAD_DIM = 64
A_Q_HEADS = 8
A_KV_HEADS = 2
A_GROUP = A_Q_HEADS // A_KV_HEADS
B_WINDOWS = (128, 512, 2048)
B_DILATIONS = (1, 4, 16)
B_N_GROUPS = len(B_WINDOWS)
B_HEADS_PER_GROUP = 4
B_HEADS = B_N_GROUPS * B_HEADS_PER_GROUP
D_FF = 4 * D_MODEL
GRID_W = 64
AXIAL_THETA = 10000.0
PARTIAL_THETA = 500000.0
PARTIAL_ROPE_DIM = HEAD_DIM // 4
Q_BLOCK = 128
EPS = 1e-6

A_Q_W = A_Q_HEADS * HEAD_DIM
A_KV_W = A_KV_HEADS * HEAD_DIM
B_W = B_HEADS * HEAD_DIM
B_OUT_W = B_HEADS_PER_GROUP * HEAD_DIM
IN_SPLITS = (A_Q_W, A_KV_W, A_KV_W, B_W, B_W, B_W, D_MODEL, D_MODEL)
IN_W = sum(IN_SPLITS)

kernel_name = "hybrid_axial_gqa_dilated_encoder"


def rmsnorm(x, g):
    xf = x.astype(jnp.float32)
    y = xf * lax.rsqrt(jnp.mean(xf * xf, axis=-1, keepdims=True) + EPS)
    return (y * g.astype(jnp.float32)).astype(x.dtype)


def rope(x, pos, theta):
    d = x.shape[-1]
    d2 = d // 2
    freqs = theta ** (-(jnp.arange(d2, dtype=jnp.float32) * 2.0) / d)
    ang = pos.astype(jnp.float32)[:, None] * freqs[None, :]
    bshape = (pos.shape[0],) + (1,) * (x.ndim - 3) + (d2,)
    cos = jnp.cos(ang).reshape(bshape)
    sin = jnp.sin(ang).reshape(bshape)
    xf = x.astype(jnp.float32)
    x1, x2 = xf[..., :d2], xf[..., d2:]
    return jnp.concatenate([x1 * cos - x2 * sin, x2 * cos + x1 * sin], axis=-1).astype(x.dtype)


def axial_gqa(q, k, v, q_gain, k_gain):
    Bn, S = q.shape[0], q.shape[1]
    rows = S // GRID_W
    r, c = jnp.meshgrid(jnp.arange(rows), jnp.arange(GRID_W), indexing="ij")
    r = r.reshape(-1)
    c = c.reshape(-1)
    q = rmsnorm(q, q_gain)
    k = rmsnorm(k, k_gain)
    half = HEAD_DIM // 2

    def axial(t):
        return jnp.concatenate([rope(t[..., :half], r, AXIAL_THETA),
                                rope(t[..., half:], c, AXIAL_THETA)], axis=-1)

    q = axial(q)
    k = axial(k)
    nb = S // Q_BLOCK
    qb = q.reshape(Bn, nb, Q_BLOCK, A_KV_HEADS, A_GROUP, HEAD_DIM).transpose(1, 0, 2, 3, 4, 5)
    scale = HEAD_DIM ** -0.5

    def block(qi):
        s = jnp.einsum("bqkgd,bskd->bkgqs", qi, k).astype(jnp.float32) * scale
        p = jax.nn.softmax(s, axis=-1)
        return jnp.einsum("bkgqs,bskd->bqkgd", p.astype(v.dtype), v)

    o = lax.map(block, qb)
    return o.transpose(1, 0, 2, 3, 4, 5).reshape(Bn, S, A_Q_W)


def dilated_attention(q, k, v):
    Bn, S = q.shape[0], q.shape[1]
    t = jnp.arange(S)

    def prope(x):
        return jnp.concatenate([rope(x[..., :PARTIAL_ROPE_DIM], t, PARTIAL_THETA),
                                x[..., PARTIAL_ROPE_DIM:]], axis=-1)

    q = prope(q)
    k = prope(k)
    offs = jnp.stack([jnp.arange(-(w // 2) // d, (w // 2) // d + 1) * d
                      for w, d in zip(B_WINDOWS, B_DILATIONS)])
    nb = S // Q_BLOCK
    qb = q.reshape(Bn, nb, Q_BLOCK, B_N_GROUPS, B_HEADS_PER_GROUP, HEAD_DIM).transpose(1, 0, 2, 3, 4, 5)
    starts = jnp.arange(nb) * Q_BLOCK
    g_idx = jnp.arange(B_N_GROUPS)[None, :, None]
    scale = HEAD_DIM ** -0.5

    def block(args):
        qi, s0 = args
        idx = s0 + jnp.arange(Q_BLOCK)[:, None, None] + offs[None]
        valid = (idx >= 0) & (idx < S)
        idxc = jnp.clip(idx, 0, S - 1)
        kg = k[:, idxc, g_idx]
        vg = v[:, idxc, g_idx]
        s = jnp.einsum("bqghd,bqgjhd->bqghj", qi, kg).astype(jnp.float32) * scale
        s = jnp.where(valid[None, :, :, None, :], s, -jnp.inf)
        m = jnp.max(s, axis=-1, keepdims=True)
        p = jnp.exp(s - m)
        den = jnp.sum(p, axis=-1, keepdims=True)
        o = jnp.einsum("bqghj,bqgjhd->bqghd", (p / den).astype(v.dtype), vg)
        lse = (m + jnp.log(den))[..., 0]
        w = jax.nn.softmax(lse, axis=2)
        return jnp.einsum("bqgh,bqghd->bqhd", w.astype(o.dtype), o)

    o = lax.map(block, (qb, starts))
    return o.transpose(1, 0, 2, 3, 4).reshape(Bn, S, B_OUT_W)


def layer(x, w_in, w_a_out, w_b_out, w_out, g_mix, q_gain, k_gain, g_mlp, w_up, w_down):
    Bn, S, _ = x.shape
    h = rmsnorm(x, g_mix)
    z = h @ w_in
    cuts = [int(c) for c in np.cumsum(IN_SPLITS)[:-1]]
    qa, ka, va, qb, kb, vb, ga, gb = jnp.split(z, cuts, axis=-1)
    ya = axial_gqa(qa.reshape(Bn, S, A_Q_HEADS, HEAD_DIM),
                   ka.reshape(Bn, S, A_KV_HEADS, HEAD_DIM),
                   va.reshape(Bn, S, A_KV_HEADS, HEAD_DIM), q_gain, k_gain) @ w_a_out
    bshape = (Bn, S, B_N_GROUPS, B_HEADS_PER_GROUP, HEAD_DIM)
    yb = dilated_attention(qb.reshape(bshape), kb.reshape(bshape), vb.reshape(bshape)) @ w_b_out
    mixed = jax.nn.sigmoid(ga) * ya + jax.nn.sigmoid(gb) * yb
    x = x + mixed @ w_out
    h = rmsnorm(x, g_mlp)
    u = jnp.square(jax.nn.relu(h @ w_up))
    return x + u @ w_down


def trunk(x, w_in, w_a_out, w_b_out, w_out, g_mix, q_gain, k_gain, g_mlp, w_up, w_down, g_final):
    for l in range(DEPTH):
        x = layer(x, w_in[l], w_a_out[l], w_b_out[l], w_out[l], g_mix[l], q_gain[l], k_gain[l],
                  g_mlp[l], w_up[l], w_down[l])
    return rmsnorm(x, g_final)


def setup_inputs(seed: int = 0) -> dict:
    key = jax.random.key(seed)
    ks = jax.random.split(key, 13)
    f32 = jnp.float32

    def w(k, shape, fan_in):
        return jax.random.normal(k, shape, f32) * (fan_in ** -0.5)

    def gain(k, shape):
        return 1.0 + 0.02 * jax.random.normal(k, shape, f32)

    return {
        "x_prompt": jax.random.normal(ks[0], (BATCH, SEQ, D_MODEL), f32),
        "x_sample": jax.random.normal(ks[1], (DEC_BATCH, DEC_SEQ, D_MODEL), f32),
        "w_in": w(ks[2], (DEPTH, D_MODEL, IN_W), D_MODEL),
        "w_a_out": w(ks[3], (DEPTH, A_Q_W, D_MODEL), A_Q_W),
        "w_b_out": w(ks[4], (DEPTH, B_OUT_W, D_MODEL), B_OUT_W),
        "w_out": w(ks[5], (DEPTH, D_MODEL, D_MODEL), D_MODEL),
        "g_mix": gain(ks[6], (DEPTH, D_MODEL)),
        "q_gain": gain(ks[7], (DEPTH, HEAD_DIM)),
        "k_gain": gain(ks[8], (DEPTH, HEAD_DIM)),
        "g_mlp": gain(ks[9], (DEPTH, D_MODEL)),
        "w_up": w(ks[10], (DEPTH, D_MODEL, D_FF), D_MODEL),
        "w_down": w(ks[11], (DEPTH, D_FF, D_MODEL), D_FF),
        "g_final": gain(ks[12], (D_MODEL,)),
    }


def reference(x_prompt, x_sample, w_in, w_a_out, w_b_out, w_out, g_mix, q_gain, k_gain,
              g_mlp, w_up, w_down, g_final):
    y_prompt = trunk(x_prompt, w_in, w_a_out, w_b_out, w_out, g_mix, q_gain, k_gain,
                     g_mlp, w_up, w_down, g_final)
    y_sample = trunk(x_sample, w_in, w_a_out, w_b_out, w_out, g_mix, q_gain, k_gain,
                     g_mlp, w_up, w_down, g_final)
    return (y_prompt, y_sample)
```

```cpp
#include <hip/hip_runtime.h>
#include <hip/hip_cooperative_groups.h>
#include <hip/hip_bf16.h>
#include <cstdio>
#include <cstdint>
#include <cmath>
namespace cg = cooperative_groups;
constexpr int MTOK = 49152, MPROMPT = 16384;
constexpr float RMS_EPS = 1e-6f;
constexpr float QSCALE = 0.125f * 1.4426950408889634f;
namespace pg8 {
#define PG8_LAS __attribute__((address_space(3)))
typedef unsigned short bf16_t;
typedef short bf16x8 __attribute__((ext_vector_type(8)));
typedef float f32x4 __attribute__((ext_vector_type(4)));
typedef unsigned u32x4 __attribute__((ext_vector_type(4)));
constexpr int BM = 256, BK = 64, HALF = 128, HTB = HALF * BK * 2  , STAGE_BYTES = 8 * HTB, NXCD = 8, WGM = 8;

__host__ __device__ __forceinline__ int lds_byte(int r, int c) { const int st = (r >> 4) * 2 + (c >> 5), rr = r & 15, cc = c & 31, ob = rr * 64 + cc * 2; return st * 1024 + (ob ^ (((ob >> 9) & 1) << 5)); }
__host__ __device__ __forceinline__ void stage_rc(int b, int& R, int& C) { const int st = b / 1024, sb = b % 1024, swz = sb ^ (((sb >> 9) & 1) << 5); R = (st >> 1) * 16 + swz / 64; C = (st & 1) * 32 + (swz % 64) / 2; }
__host__ __device__ __forceinline__ int perm32(int rho) { const int n = rho >> 4, i = rho & 15; return 8 * (i >> 2) + 4 * n + (i & 3); }

struct Unit { int pm, pn; };
struct Gemm { const bf16_t* A; const bf16_t* Bt; int M, N, K; };

struct StaticOrder {
    int nM, nN, nwg, G, c;
    __host__ __device__ void init(int M, int N, int G_, int c_) { nM = M / BM; nN = N / BM; nwg = nM * nN; G = G_; c = c_; }
    __host__ __device__ bool next(int i, Unit& u) const {
        const long L = (long)i * G + c; if (L >= nwg) return false;
        int wgid = (int)L; { const int q = nwg / NXCD, r = nwg % NXCD, xcd = wgid % NXCD, off = wgid / NXCD; wgid = (xcd < r ? xcd * (q + 1) : r * (q + 1) + (xcd - r) * q) + off; }
        const int nig = WGM * nN, gid = wgid / nig, fm = gid * WGM, gsz = (nM - fm) < WGM ? (nM - fm) : WGM;
        u.pm = fm + ((wgid % nig) % gsz); u.pn = (wgid % nig) / gsz; return true;
    }
    __device__ __forceinline__ void a_ready(const Unit&) const {}
    __device__ __forceinline__ void done(const Unit&) const {}
};

typedef float f32x2c_t __attribute__((ext_vector_type(2))); typedef __bf16 bf16x2c_t __attribute__((ext_vector_type(2)));
__device__ __forceinline__ unsigned cvt_pk_bf16(float lo, float hi) { f32x2c_t v = {lo, hi}; bf16x2c_t b = __builtin_convertvector(v, bf16x2c_t); return __builtin_bit_cast(unsigned, b); }
typedef float f32x2v __attribute__((ext_vector_type(2)));
__device__ __forceinline__ void st8(bf16_t* p, const float (&v)[8]) {
    u32x4 w; w.x = cvt_pk_bf16(v[0], v[1]); w.y = cvt_pk_bf16(v[2], v[3]); w.z = cvt_pk_bf16(v[4], v[5]); w.w = cvt_pk_bf16(v[6], v[7]); *(u32x4*)p = w;
}
__device__ __forceinline__ void ld8(const bf16_t* p, float (&v)[8]) {
    const u32x4 w = *(const u32x4*)p;
    v[0] = __uint_as_float(w.x << 16); v[1] = __uint_as_float(w.x & 0xffff0000u); v[2] = __uint_as_float(w.y << 16); v[3] = __uint_as_float(w.y & 0xffff0000u);
    v[4] = __uint_as_float(w.z << 16); v[5] = __uint_as_float(w.z & 0xffff0000u); v[6] = __uint_as_float(w.w << 16); v[7] = __uint_as_float(w.w & 0xffff0000u);
}
#define ACC8(dst, ai, bj, m) do { const f32x4 a0_ = acc[ai][bj][m][0], a1_ = acc[ai][bj][m][1]; dst[0] = a0_[0]; dst[1] = a0_[1]; dst[2] = a0_[2]; dst[3] = a0_[3]; dst[4] = a1_[0]; dst[5] = a1_[1]; dst[6] = a1_[2]; dst[7] = a1_[3]; } while (0)

struct Epi1 {
    static constexpr bool PERM = true, AFTER_DRAIN = false;
    bf16_t *QA, *QB, *GA; const float* gains; const float* T1; const float* T2;
    static constexpr size_t KA_OFF = (size_t)48 * 1048576 / 2, VA_OFF = (size_t)60 * 1048576 / 2, QKV_STRIDE = (size_t)72 * 1048576 / 2;
    __device__ __forceinline__ void operator()(const f32x4 (&acc)[2][2][4][2], const Unit& u, int wr, int wc, int fr, int fq) const {
        const int pn = u.pn, r0 = u.pm * BM;
        int seqbase, lgS; if (r0 < MPROMPT) { lgS = 12; seqbase = r0 & ~4095; } else { lgS = 11; seqbase = MPROMPT + ((r0 - MPROMPT) & ~2047); }
        if (pn >= 12) {
            bf16_t* G = GA + (pn < 16 ? (size_t)0 : (size_t)MTOK * 1024); const int cb = ((pn - 12) & 3) * 256 + wc * 32 + fq * 8;
#pragma unroll
            for (int ai = 0; ai < 2; ++ai)
#pragma unroll
                for (int m = 0; m < 4; ++m) { const size_t row = (size_t)(r0 + ai * HALF + wr * 64 + m * 16 + fr);
#pragma unroll
                    for (int bj = 0; bj < 2; ++bj) { float v[8]; ACC8(v, ai, bj, m);
#pragma unroll
                        for (int e = 0; e < 8; ++e) v[e] = __builtin_amdgcn_rcpf(1.0f + __builtin_amdgcn_exp2f(-1.4426950408889634f * v[e]));
                        st8(G + row * 1024 + cb + bj * HALF, v); } }
        } else if (pn >= 3) {
            const int kind = (pn - 3) / 3, g = (pn - 3) - 3 * kind, sh = 2 * g, lgL = lgS - sh;
            bf16_t* dst = QB + (size_t)kind * QKV_STRIDE + (size_t)g * MTOK * 256 + wc * 64 + fq * 8;
#pragma unroll
            for (int ai = 0; ai < 2; ++ai)
#pragma unroll
                for (int m = 0; m < 4; ++m) { const int row = r0 + ai * HALF + wr * 64 + m * 16 + fr, t = row - seqbase;
                    const size_t rowp = (size_t)(seqbase + ((t & ((1 << sh) - 1)) << lgL) + (t >> sh));
                    float v0[8], v1[8]; ACC8(v0, ai, 0, m); ACC8(v1, ai, 1, m);
                    if (kind < 2) {
                        const f32x4* tp = (const f32x4*)(T2 + (size_t)t * 16);
#pragma unroll
                        for (int k = 0; k < 4; ++k) { const f32x4 cs = tp[k];
                            { const float p = __shfl_xor(v0[2 * k], 16); const float o = v0[2 * k] * cs[0] + (fq == 0 ? -p : p) * cs[1]; v0[2 * k] = fq < 2 ? o : v0[2 * k]; }
                            { const float p = __shfl_xor(v0[2 * k + 1], 16); const float o = v0[2 * k + 1] * cs[2] + (fq == 0 ? -p : p) * cs[3]; v0[2 * k + 1] = fq < 2 ? o : v0[2 * k + 1]; } }
                        if (kind == 0) {
#pragma unroll
                            for (int e = 0; e < 8; ++e) { v0[e] *= QSCALE; v1[e] *= QSCALE; } }
                    }
                    st8(dst + rowp * 256, v0); st8(dst + rowp * 256 + 32, v1); }
        } else if (pn == 2 && wc >= 2) {
#pragma unroll
            for (int ai = 0; ai < 2; ++ai)
#pragma unroll
                for (int m = 0; m < 4; ++m) { const size_t row = (size_t)(r0 + ai * HALF + wr * 64 + m * 16 + fr);
#pragma unroll
                    for (int bj = 0; bj < 2; ++bj) { float v[8]; ACC8(v, ai, bj, m); st8(QA + VA_OFF + row * 128 + (wc - 2) * 64 + bj * 32 + fq * 8, v); } }
        } else {
            const bool isq = pn < 2; const float* gn = gains + (isq ? 0 : 64);
            float gv[2][8];
#pragma unroll
            for (int bj = 0; bj < 2; ++bj)
#pragma unroll
                for (int e = 0; e < 8; ++e) gv[bj][e] = gn[32 * bj + 8 * fq + e];
            bf16_t* dst = QA + (isq ? (size_t)((pn * 4 + wc) * 64) : KA_OFF + (size_t)(wc * 64)) + fq * 8; const int pitch = isq ? 512 : 128;
            const float osc = isq ? QSCALE : 1.0f;
#pragma unroll
            for (int ai = 0; ai < 2; ++ai)
#pragma unroll
                for (int m = 0; m < 4; ++m) { const int row = r0 + ai * HALF + wr * 64 + m * 16 + fr, t = row - seqbase;
                    float v[2][8]; ACC8(v[0], ai, 0, m); ACC8(v[1], ai, 1, m);
                    float ss = 0.f;
#pragma unroll
                    for (int bj = 0; bj < 2; ++bj)
#pragma unroll
                        for (int e = 0; e < 8; ++e) ss += v[bj][e] * v[bj][e];
                    ss += __shfl_xor(ss, 16); ss += __shfl_xor(ss, 32);
                    const float rinv = 1.0f / sqrtf(ss * (1.0f / 64.0f) + RMS_EPS);
#pragma unroll
                    for (int bj = 0; bj < 2; ++bj) { const int pos = bj == 0 ? (t >> 6) : (t & 63);
                        const f32x4* tp = (const f32x4*)(T1 + (size_t)pos * 32 + 16 * (fq & 1));
                        float o[8];
#pragma unroll
                        for (int k = 0; k < 4; ++k) { const f32x4 cs = tp[k];
                            { const float y = v[bj][2 * k] * rinv * gv[bj][2 * k]; const float p = __shfl_xor(y, 32); o[2 * k] = (y * cs[0] + (fq < 2 ? -p : p) * cs[1]) * osc; }
                            { const float y = v[bj][2 * k + 1] * rinv * gv[bj][2 * k + 1]; const float p = __shfl_xor(y, 32); o[2 * k + 1] = (y * cs[2] + (fq < 2 ? -p : p) * cs[3]) * osc; } }
                        st8(dst + (size_t)row * pitch + bj * 32, o); } }
        }
    }
};
struct Epi3a {
    static constexpr bool PERM = true, AFTER_DRAIN = false; const bf16_t* GA; bf16_t* MIX;
    __device__ __forceinline__ void operator()(const f32x4 (&acc)[2][2][4][2], const Unit& u, int wr, int wc, int fr, int fq) const {
        const int col0 = u.pn * BM + wc * 32 + fq * 8;
#pragma unroll
        for (int ai = 0; ai < 2; ++ai)
#pragma unroll
            for (int m = 0; m < 4; ++m) { const size_t row = (size_t)(u.pm * BM + ai * HALF + wr * 64 + m * 16 + fr);
#pragma unroll
                for (int bj = 0; bj < 2; ++bj) { float v[8], gq[8]; ACC8(v, ai, bj, m); ld8(GA + row * 1024 + col0 + bj * HALF, gq);
#pragma unroll
                    for (int e = 0; e < 8; ++e) v[e] *= gq[e];
                    st8(MIX + row * 1024 + col0 + bj * HALF, v); } }
    }
};
struct Epi3b {
    static constexpr bool PERM = true, AFTER_DRAIN = false; const bf16_t* GB; bf16_t* MIX;
    __device__ __forceinline__ void operator()(const f32x4 (&acc)[2][2][4][2], const Unit& u, int wr, int wc, int fr, int fq) const {
        const int col0 = u.pn * BM + wc * 32 + fq * 8;
#pragma unroll
        for (int ai = 0; ai < 2; ++ai)
#pragma unroll
            for (int m = 0; m < 4; ++m) { const size_t row = (size_t)(u.pm * BM + ai * HALF + wr * 64 + m * 16 + fr);
#pragma unroll
                for (int bj = 0; bj < 2; ++bj) { float v[8], gq[8], mx[8]; ACC8(v, ai, bj, m); ld8(GB + row * 1024 + col0 + bj * HALF, gq); ld8(MIX + row * 1024 + col0 + bj * HALF, mx);
#pragma unroll
                    for (int e = 0; e < 8; ++e) v[e] = mx[e] + v[e] * gq[e];
                    st8(MIX + row * 1024 + col0 + bj * HALF, v); } }
    }
};
struct Epi4 {
    static constexpr bool PERM = true, AFTER_DRAIN = false; const float* XP; long long xs_delta; float* X1; bf16_t* H2; const float* gm; float* SS;
    __device__ __forceinline__ void operator()(const f32x4 (&acc)[2][2][4][2], const Unit& u, int wr, int wc, int fr, int fq) const {
        const int col0 = u.pn * BM + wc * 32 + fq * 8, r0 = u.pm * BM;
        const float* X = (const float*)((const char*)XP + (r0 < MPROMPT ? 0ll : xs_delta)) + (size_t)r0 * 1024;
        float gv[2][8];
#pragma unroll
        for (int bj = 0; bj < 2; ++bj)
#pragma unroll
            for (int e = 0; e < 8; ++e) gv[bj][e] = gm[col0 + bj * HALF + e];
#pragma unroll
        for (int ai = 0; ai < 2; ++ai)
#pragma unroll
            for (int m = 0; m < 4; ++m) { const int rl = ai * HALF + wr * 64 + m * 16 + fr; const size_t row = (size_t)(r0 + rl); float ss = 0.f;
#pragma unroll
                for (int bj = 0; bj < 2; ++bj) { const float* xp = X + (size_t)rl * 1024 + col0 + bj * HALF; const f32x4 x0 = *(const f32x4*)xp, x1v = *(const f32x4*)(xp + 4);
                    const f32x4 y0 = x0 + acc[ai][bj][m][0], y1 = x1v + acc[ai][bj][m][1];
                    float* op = X1 + row * 1024 + col0 + bj * HALF; *(f32x4*)op = y0; *(f32x4*)(op + 4) = y1;
                    ss += (y0[0] * y0[0] + y0[1] * y0[1]) + (y0[2] * y0[2] + y0[3] * y0[3]) + (y1[0] * y1[0] + y1[1] * y1[1]) + (y1[2] * y1[2] + y1[3] * y1[3]);
                    float h[8] = {y0[0] * gv[bj][0], y0[1] * gv[bj][1], y0[2] * gv[bj][2], y0[3] * gv[bj][3], y1[0] * gv[bj][4], y1[1] * gv[bj][5], y1[2] * gv[bj][6], y1[3] * gv[bj][7]};
                    st8(H2 + row * 1024 + col0 + bj * HALF, h); }
                ss += __shfl_xor(ss, 16); ss += __shfl_xor(ss, 32);
                if (fq == 0) SS[row * 16 + u.pn * 4 + wc] = ss; }
    }
};
struct Epi5 {
    static constexpr bool PERM = true, AFTER_DRAIN = false; bf16_t* U; const float* SS;
    __device__ __forceinline__ void operator()(const f32x4 (&acc)[2][2][4][2], const Unit& u, int wr, int wc, int fr, int fq) const {
        const int col0 = u.pn * BM + wc * 32 + fq * 8;
#pragma unroll
        for (int ai = 0; ai < 2; ++ai)
#pragma unroll
            for (int m = 0; m < 4; ++m) { const size_t row = (size_t)(u.pm * BM + ai * HALF + wr * 64 + m * 16 + fr);
                const f32x4* sp = (const f32x4*)(SS + row * 16); const f32x4 s0 = sp[0], s1 = sp[1], s2 = sp[2], s3 = sp[3];
                const f32x4 sv = (s0 + s1) + (s2 + s3); const float tot = (sv[0] + sv[1]) + (sv[2] + sv[3]);
                const float r2 = 1.0f / (tot * (1.0f / 1024.0f) + RMS_EPS);
#pragma unroll
                for (int bj = 0; bj < 2; ++bj) { float v[8]; ACC8(v, ai, bj, m);
#pragma unroll
                    for (int e = 0; e < 8; ++e) { const float a = fmaxf(v[e], 0.f); v[e] = a * a * r2; }
                    st8(U + row * 4096 + col0 + bj * HALF, v); } }
    }
};
struct Epi6 {
    static constexpr bool PERM = true, AFTER_DRAIN = false; float* Y; float* SS;
    __device__ __forceinline__ void operator()(const f32x4 (&acc)[2][2][4][2], const Unit& u, int wr, int wc, int fr, int fq) const {
        const int col0 = u.pn * BM + wc * 32 + fq * 8;
#pragma unroll
        for (int ai = 0; ai < 2; ++ai)
#pragma unroll
            for (int m = 0; m < 4; ++m) { const size_t row = (size_t)(u.pm * BM + ai * HALF + wr * 64 + m * 16 + fr); float ss = 0.f;
#pragma unroll
                for (int bj = 0; bj < 2; ++bj) { float* op = Y + row * 1024 + col0 + bj * HALF; const f32x4 x0 = *(const f32x4*)op, x1v = *(const f32x4*)(op + 4);
                    const f32x4 y0 = x0 + acc[ai][bj][m][0], y1 = x1v + acc[ai][bj][m][1];
                    *(f32x4*)op = y0; *(f32x4*)(op + 4) = y1;
                    ss += (y0[0] * y0[0] + y0[1] * y0[1]) + (y0[2] * y0[2] + y0[3] * y0[3]) + (y1[0] * y1[0] + y1[1] * y1[1]) + (y1[2] * y1[2] + y1[3] * y1[3]); }
                ss += __shfl_xor(ss, 16); ss += __shfl_xor(ss, 32);
                if (fq == 0) SS[row * 16 + u.pn * 4 + wc] = ss; }
    }
};
#undef ACC8
template <class Epi, class Sched, bool ALIGN_EPI = false, bool SP2 = false>
__device__ __forceinline__ void gemm_phase(PG8_LAS unsigned char* lds, const Gemm g, const Sched& S, const Epi& E) {
    int tid_l = threadIdx.x; asm volatile("" : "+v"(tid_l));
    const int tid = tid_l, wid = __builtin_amdgcn_readfirstlane(tid >> 6), lane = tid & 63, wr = wid >> 2, wc = wid & 3, fr = lane & 15, fq = lane >> 4;
    const int K = g.K, nt = K / BK;
    unsigned voffA[2], voffB[2];
#pragma unroll
    for (int i = 0; i < 2; ++i) { int R, C; stage_rc(tid * 16 + i * 8192, R, C); const int Rb = Epi::PERM ? ((R & ~31) + perm32(R & 31)) : R;
        voffA[i] = (unsigned)(R * K + C) * 2u; voffB[i] = (unsigned)(Rb * K + C) * 2u; }
    const size_t kstep = (size_t)(BK * 2);
    const size_t hstep = (size_t)HALF * K * 2;
    const size_t tstep = 2 * hstep;
    const unsigned ldsw = (unsigned)wid * 1024u;
    const int aoff = lds_byte(wr * 64 + fr, fq * 8), boff = lds_byte(wc * 32 + fr, fq * 8);
#define PG8_SA(b, h) (((b) * 2 + (h)) * HTB)
#define PG8_SB(b, h) ((4 + (b) * 2 + (h)) * HTB)
#define PG8_STAGE(bufoff, gbase, voff) do { _Pragma("unroll") for (int _i = 0; _i < 2; ++_i) \
        __builtin_amdgcn_global_load_lds((const unsigned*)((const char*)(gbase) + (voff)[_i]), (PG8_LAS unsigned*)(lds + (bufoff) + ldsw + _i * 8192), 16, 0, 0); } while (0)
#define PG8_LDA(dst, b, h) do { _Pragma("unroll") for (int m = 0; m < 4; ++m) _Pragma("unroll") for (int k = 0; k < 2; ++k) dst[m][k] = *(const PG8_LAS bf16x8*)(lds + PG8_SA(b, h) + aoff + m * 2048 + k * 1024); } while (0)
#define PG8_LDB(dst, b, h) do { _Pragma("unroll") for (int n = 0; n < 2; ++n) _Pragma("unroll") for (int k = 0; k < 2; ++k) dst[n][k] = *(const PG8_LAS bf16x8*)(lds + PG8_SB(b, h) + boff + n * 2048 + k * 1024); } while (0)
#define PG8_MMA(ai, bj, At, Bt) do { __builtin_amdgcn_s_setprio(1); _Pragma("unroll") for (int m = 0; m < 4; ++m) _Pragma("unroll") for (int n = 0; n < 2; ++n) _Pragma("unroll") for (int k = 0; k < 2; ++k) \
        acc[ai][bj][m][n] = __builtin_amdgcn_mfma_f32_16x16x32_bf16(Bt[n][k], At[m][k], acc[ai][bj][m][n], 0, 0, 0); __builtin_amdgcn_s_setprio(0); } while (0)
#define PG8_WAIT_V(n) asm volatile("s_waitcnt vmcnt(" #n ")" ::: "memory")
#define PG8_WAIT_L(n) asm volatile("s_waitcnt lgkmcnt(" #n ")" ::: "memory")
#define PG8_BAR __builtin_amdgcn_s_barrier()
#define PG8_SCHED __builtin_amdgcn_sched_barrier(0)
    Unit cur, nxt; int ui = 0;
    if (!S.next(0, cur)) return;
    f32x4 acc[2][2][4][2];
#pragma unroll
    for (int a = 0; a < 2; ++a)
#pragma unroll
        for (int b = 0; b < 2; ++b)
#pragma unroll
            for (int m = 0; m < 4; ++m)
#pragma unroll
                for (int n = 0; n < 2; ++n) acc[a][b][m][n] = (f32x4){0.f, 0.f, 0.f, 0.f};
    bf16x8 At[4][2], B0[2][2], B1[2][2];
    const char* cA = (const char*)g.A + (size_t)cur.pm * tstep; const char* cB = (const char*)g.Bt + (size_t)cur.pn * tstep;
    S.a_ready(cur);
    if constexpr (SP2) {
        PG8_STAGE(PG8_SB(0, 0), cB, voffB); PG8_STAGE(PG8_SB(0, 1), cB + hstep, voffB); PG8_STAGE(PG8_SA(0, 0), cA, voffA); PG8_STAGE(PG8_SA(0, 1), cA + hstep, voffA);
        if (wr == 1) PG8_BAR;
        PG8_WAIT_V(2); PG8_BAR;
        PG8_STAGE(PG8_SB(1, 0), cB + kstep, voffB); PG8_STAGE(PG8_SA(1, 0), cA + kstep, voffA); PG8_STAGE(PG8_SB(1, 1), cB + hstep + kstep, voffB);
        PG8_WAIT_V(6); PG8_BAR;
    } else {
        PG8_STAGE(PG8_SB(0, 0), cB, voffB); PG8_STAGE(PG8_SA(0, 0), cA, voffA); PG8_STAGE(PG8_SB(0, 1), cB + hstep, voffB); PG8_STAGE(PG8_SA(0, 1), cA + hstep, voffA);
        if (wr == 1) PG8_BAR;
        PG8_WAIT_V(4); PG8_BAR;
        PG8_STAGE(PG8_SB(1, 0), cB + kstep, voffB); PG8_STAGE(PG8_SA(1, 0), cA + kstep, voffA); PG8_STAGE(PG8_SB(1, 1), cB + hstep + kstep, voffB);
        PG8_WAIT_V(6); PG8_BAR;
    }
    for (;;) {
        const bool has_next = S.next(ui + 1, nxt);
        const char* nA = has_next ? (const char*)g.A + (size_t)nxt.pm * tstep : cA; const char* nB = has_next ? (const char*)g.Bt + (size_t)nxt.pn * tstep : cB;
        for (int t = 0; t < nt; t += 2) {
            const bool last = (t == nt - 2);
            const char* a1 = cA + (size_t)(t + 1) * kstep;
            const char* a2 = last ? nA : cA + (size_t)(t + 2) * kstep; const char* b2 = last ? nB : cB + (size_t)(t + 2) * kstep;
            const char* a3 = a2 + kstep; const char* b3 = b2 + kstep;
            if (last && has_next) S.a_ready(nxt);
            if constexpr (SP2) {
            PG8_LDB(B0, 0, 0); PG8_LDB(B1, 0, 1); PG8_SCHED; PG8_LDA(At, 0, 0); PG8_STAGE(PG8_SA(1, 1), a1 + hstep, voffA);
            PG8_WAIT_V(8); PG8_WAIT_L(0); PG8_BAR; PG8_MMA(0, 0, At, B0); PG8_MMA(0, 1, At, B1); PG8_BAR; PG8_SCHED;
            PG8_LDA(At, 0, 1); PG8_STAGE(PG8_SB(0, 0), b2, voffB); PG8_STAGE(PG8_SB(0, 1), b2 + hstep, voffB); PG8_STAGE(PG8_SA(0, 0), a2, voffA);
            PG8_WAIT_V(8); PG8_WAIT_L(0); PG8_BAR; PG8_MMA(1, 0, At, B0); PG8_MMA(1, 1, At, B1); PG8_BAR; PG8_SCHED;
            PG8_LDB(B0, 1, 0); PG8_LDB(B1, 1, 1); PG8_SCHED; PG8_LDA(At, 1, 0); PG8_STAGE(PG8_SA(0, 1), a2 + hstep, voffA);
            PG8_WAIT_V(8); PG8_WAIT_L(0); PG8_BAR; PG8_MMA(0, 0, At, B0); PG8_MMA(0, 1, At, B1); PG8_BAR; PG8_SCHED;
            PG8_LDA(At, 1, 1); PG8_STAGE(PG8_SB(1, 0), b3, voffB); PG8_STAGE(PG8_SB(1, 1), b3 + hstep, voffB); PG8_STAGE(PG8_SA(1, 0), a3, voffA);
            PG8_WAIT_V(8); PG8_WAIT_L(0); PG8_BAR; PG8_MMA(1, 0, At, B0); PG8_MMA(1, 1, At, B1); PG8_BAR; PG8_SCHED;
            } else {
            PG8_LDB(B0, 0, 0); PG8_SCHED; PG8_LDA(At, 0, 0); PG8_STAGE(PG8_SA(1, 1), a1 + hstep, voffA);
            PG8_WAIT_L(8); PG8_BAR; PG8_WAIT_L(0); PG8_MMA(0, 0, At, B0); PG8_BAR; PG8_SCHED;
            PG8_LDB(B1, 0, 1); PG8_STAGE(PG8_SB(0, 0), b2, voffB);
            PG8_BAR; PG8_WAIT_L(0); PG8_MMA(0, 1, At, B1); PG8_BAR;
            PG8_LDA(At, 0, 1); PG8_STAGE(PG8_SA(0, 0), a2, voffA);
            PG8_BAR; PG8_WAIT_L(0); PG8_MMA(1, 0, At, B0); PG8_BAR; PG8_SCHED;
            PG8_STAGE(PG8_SB(0, 1), b2 + hstep, voffB);
            PG8_WAIT_V(6); PG8_BAR; PG8_MMA(1, 1, At, B1); PG8_BAR;
            PG8_LDB(B0, 1, 0); PG8_SCHED; PG8_LDA(At, 1, 0); PG8_STAGE(PG8_SA(0, 1), a2 + hstep, voffA);
            PG8_WAIT_L(8); PG8_BAR; PG8_WAIT_L(0); PG8_MMA(0, 0, At, B0); PG8_BAR; PG8_SCHED;
            PG8_LDB(B1, 1, 1); PG8_STAGE(PG8_SB(1, 0), b3, voffB);
            PG8_BAR; PG8_WAIT_L(0); PG8_MMA(0, 1, At, B1); PG8_BAR;
            PG8_LDA(At, 1, 1); PG8_STAGE(PG8_SA(1, 0), a3, voffA);
            PG8_BAR; PG8_WAIT_L(0); PG8_MMA(1, 0, At, B0); PG8_BAR; PG8_SCHED;
            PG8_STAGE(PG8_SB(1, 1), b3 + hstep, voffB);
            PG8_WAIT_V(6); PG8_BAR; PG8_MMA(1, 1, At, B1); PG8_BAR;
            }
        }
        if constexpr (ALIGN_EPI) { if (wr == 0) PG8_BAR; }
        if constexpr (!Epi::AFTER_DRAIN) { E(acc, cur, wr, wc, fr, fq); S.done(cur); }
        if (!has_next) break;
#pragma unroll
        for (int a = 0; a < 2; ++a)
#pragma unroll
            for (int b = 0; b < 2; ++b)
#pragma unroll
                for (int m = 0; m < 4; ++m)
#pragma unroll
                    for (int n = 0; n < 2; ++n) acc[a][b][m][n] = (f32x4){0.f, 0.f, 0.f, 0.f};
        cur = nxt; cA = nA; cB = nB; ++ui;
        if constexpr (ALIGN_EPI) { if (wr == 1) PG8_BAR; }
    }
    PG8_WAIT_V(0);
    if constexpr (!ALIGN_EPI) { if (wr == 0) PG8_BAR; }
    PG8_BAR;
    if constexpr (Epi::AFTER_DRAIN) { E.fused(acc, cur, wr, wc, fr, fq, lds, wid, lane); S.done(cur); }
#undef PG8_SA
#undef PG8_SB
#undef PG8_STAGE
#undef PG8_LDA
#undef PG8_LDB
#undef PG8_MMA
#undef PG8_WAIT_V
#undef PG8_WAIT_L
#undef PG8_BAR
#undef PG8_SCHED
}
}
#include <hip/hip_bf16.h>
namespace attn_body {
using bf16=__hip_bfloat16;
using bf16x8=__attribute__((ext_vector_type(8)))short;
using s16x4=__attribute__((ext_vector_type(4)))short;
using f32x16=__attribute__((ext_vector_type(16)))float;
using u32x4=__attribute__((ext_vector_type(4)))unsigned;
constexpr int D=64,QP=512,KP=128,VP=128,OP=512;
constexpr int NW=8,QBLK=32,QB=QBLK*NW,KVBLK=64;
constexpr int ATTN_UNIT_ROWS=QB;
__device__ __forceinline__ int crow(int r,int hi){return (r&3)+8*(r>>2)+4*hi;}
#define SBAR() __builtin_amdgcn_sched_barrier(0)
__device__ __forceinline__ void cmask(f32x16&p0,f32x16&p1,int jb,int qrel,int hi){
  const float NEG=-INFINITY; int kb=64*jb+4*hi;
  #pragma unroll
  for(int r=0;r<16;++r){int kv=kb+(r&3)+8*(r>>2); if(kv>qrel)p0[r]=NEG; if(kv+32>qrel)p1[r]=NEG;}
}

constexpr int NSLOT=3, SLOTB=8192;
constexpr int LDS_K=0, LDS_V=NSLOT*SLOTB, LDS_WS=2*NSLOT*SLOTB, LDS_OST=LDS_WS+NW*64*4, LDS_BYTES=LDS_OST+NW*4096;
constexpr float C2=0.125f*1.4426950408889634f;
__device__ __forceinline__ void glds16(const void*gsrc,unsigned lds_dst){unsigned keep;
  asm volatile("s_mov_b32 %0, m0\n\ts_mov_b32 m0, %2\n\ts_nop 0\n\tglobal_load_lds_dwordx4 %1, off\n\ts_mov_b32 m0, %0":"=&s"(keep):"v"(gsrc),"s"(lds_dst):"memory");}
__device__ __forceinline__ float max3f(float a,float b,float c){float r;asm("v_max3_f32 %0, %1, %2, %3":"=v"(r):"v"(a),"v"(b),"v"(c));return r;}
__device__ __forceinline__ float max2f(float a,float b){float r;asm("v_max_f32_e32 %0, %1, %2":"=v"(r):"v"(a),"v"(b));return r;}
__device__ __forceinline__ float fadd_s(float a,float b){float r;asm("v_add_f32_e32 %0, %1, %2":"=v"(r):"v"(a),"v"(b));return r;}
__device__ __forceinline__ float fsub_s(float a,float b){float r;asm("v_sub_f32_e32 %0, %1, %2":"=v"(r):"v"(a),"v"(b));return r;}
typedef float f32x2_t __attribute__((ext_vector_type(2))); typedef __bf16 bf16x2_t __attribute__((ext_vector_type(2)));
__device__ __forceinline__ unsigned cvtpk_s(float lo,float hi){f32x2_t v={lo,hi};bf16x2_t b=__builtin_convertvector(v,bf16x2_t);return __builtin_bit_cast(unsigned,b);}
#define WAIT_BAR(N) asm volatile("s_waitcnt vmcnt(" #N ") lgkmcnt(0)\n\ts_barrier":::"memory")

__device__ __forceinline__ void qkt(f32x16&p0,f32x16&p1,const char*Kslot,const bf16x8*qr,const f32x16&negm,int r32,int hi){
  const char*kb=Kslot+hi*1024+r32*16;
  #pragma unroll
  for(int d0=0;d0<4;++d0){
    const bf16x8 b0=*reinterpret_cast<const bf16x8*>(kb+d0*2048);
    const bf16x8 b1=*reinterpret_cast<const bf16x8*>(kb+d0*2048+512);
    if(d0==0){p0=__builtin_amdgcn_mfma_f32_32x32x16_bf16(b0,qr[0],negm,0,0,0);p1=__builtin_amdgcn_mfma_f32_32x32x16_bf16(b1,qr[0],negm,0,0,0);}
    else{p0=__builtin_amdgcn_mfma_f32_32x32x16_bf16(b0,qr[d0],p0,0,0,0);p1=__builtin_amdgcn_mfma_f32_32x32x16_bf16(b1,qr[d0],p1,0,0,0);}}
}
typedef __attribute__((address_space(3))) const char* lds_cptr;
typedef short v4i16_t __attribute__((ext_vector_type(4)));
__device__ __forceinline__ void kload8(bf16x8*kf,lds_cptr kp){
  kf[0]=*(const __attribute__((address_space(3))) bf16x8*)(kp);      kf[1]=*(const __attribute__((address_space(3))) bf16x8*)(kp+512);
  kf[2]=*(const __attribute__((address_space(3))) bf16x8*)(kp+2048); kf[3]=*(const __attribute__((address_space(3))) bf16x8*)(kp+2560);
  kf[4]=*(const __attribute__((address_space(3))) bf16x8*)(kp+4096); kf[5]=*(const __attribute__((address_space(3))) bf16x8*)(kp+4608);
  kf[6]=*(const __attribute__((address_space(3))) bf16x8*)(kp+6144); kf[7]=*(const __attribute__((address_space(3))) bf16x8*)(kp+6656);
}
__device__ __forceinline__ void kload2(bf16x8*kf,lds_cptr kp,int j){ kf[2*j]=*(const __attribute__((address_space(3))) bf16x8*)(kp+j*2048); kf[2*j+1]=*(const __attribute__((address_space(3))) bf16x8*)(kp+j*2048+512); }
__device__ __forceinline__ s16x4 vtr(lds_cptr p){ return __builtin_bit_cast(s16x4,__builtin_amdgcn_ds_read_tr16_b64_v4i16((__attribute__((address_space(3))) v4i16_t*)p)); }
__device__ __forceinline__ float rowmax(const f32x16&p0,const f32x16&p1){
  float a=max3f(p0[0],p0[1],p1[0]),b=max3f(p0[2],p0[3],p1[1]);a=max3f(a,p1[2],p1[3]);
  #pragma unroll
  for(int r=4;r<16;r+=4){a=max3f(a,p0[r],p0[r+1]);b=max3f(b,p0[r+2],p0[r+3]);a=max3f(a,p1[r],p1[r+1]);b=max3f(b,p1[r+2],p1[r+3]);}
  const float m=max2f(a,b);
  auto rr=__builtin_amdgcn_permlane32_swap(__float_as_uint(m),__float_as_uint(m),false,false);
  return max2f(__uint_as_float(rr[0]),__uint_as_float(rr[1]));
}
__device__ __forceinline__ void pv(f32x16*o,int vb,bf16x8 pa0,bf16x8 pa1,bf16x8 pa2,bf16x8 pa3){
  #pragma unroll
  for(int d0=0;d0<2;++d0){s16x4 lo[4],hi[4];
    #pragma unroll
    for(int ks=0;ks<4;++ks){
      asm volatile("ds_read_b64_tr_b16 %0,%1 offset:%c2":"=&v"(lo[ks]):"v"(vb),"i"(d0*4096+ks*1024):"memory");
      asm volatile("ds_read_b64_tr_b16 %0,%1 offset:%c2":"=&v"(hi[ks]):"v"(vb),"i"(d0*4096+ks*1024+512):"memory");}
    asm volatile("s_waitcnt lgkmcnt(0)":::"memory");SBAR();
    #define PK(k) (bf16x8){lo[k][0],lo[k][1],lo[k][2],lo[k][3],hi[k][0],hi[k][1],hi[k][2],hi[k][3]}
    o[d0]=__builtin_amdgcn_mfma_f32_32x32x16_bf16(pa0,PK(0),o[d0],0,0,0);
    o[d0]=__builtin_amdgcn_mfma_f32_32x32x16_bf16(pa1,PK(1),o[d0],0,0,0);
    o[d0]=__builtin_amdgcn_mfma_f32_32x32x16_bf16(pa2,PK(2),o[d0],0,0,0);
    o[d0]=__builtin_amdgcn_mfma_f32_32x32x16_bf16(pa3,PK(3),o[d0],0,0,0);
    #undef PK
  }
}

#ifndef ATTN_STORE16
#define ATTN_STORE16(p,v) (*(u32x4*)(p)=(v))
#endif
template<int THRL> __device__ __forceinline__ void attn_unit(const bf16*Qu,const bf16*__restrict__ Kh,const bf16*__restrict__ Vh,bf16*Ou,const int NT,char*shm){
  int tid_l=threadIdx.x; asm volatile("":"+v"(tid_l)); const int tid=tid_l,lane=tid&63,r32=lane&31,hi=lane>>5; const int wid=__builtin_amdgcn_readfirstlane(tid>>6);
  const bf16*Qw=Qu+(long)(wid*QBLK)*QP;
  const unsigned lds0=(unsigned)(uintptr_t)shm;
  float*wsf=(float*)(shm+LDS_WS)+wid*64;
  const bf16*ksrc=Kh+(long)lane*KP+wid*8;
  const bf16*vsrc=Vh+(long)(16*(wid&3)+(lane>>2))*VP+(wid>>2)*32+(lane&3)*8;
  const unsigned kdst=lds0+LDS_K+wid*1024, vdst=lds0+LDS_V+wid*1024;
  #define DMA_K(t,slot) glds16(ksrc+(long)(t)*KVBLK*KP,(unsigned)__builtin_amdgcn_readfirstlane(kdst+(slot)))
  #define DMA_V(t,slot) glds16(vsrc+(long)(t)*KVBLK*VP,(unsigned)__builtin_amdgcn_readfirstlane(vdst+(slot)))
  const int vb0=(int)(lds0+LDS_V)+((lane>>4)&1)*32+(lane&3)*8+(4*hi+((lane&15)>>2))*64;
  const char*Kbase=shm+LDS_K; bf16x8 kf[8];
  const lds_cptr shm3=(lds_cptr)shm; const lds_cptr kp0=shm3+LDS_K+hi*1024+r32*16; const lds_cptr vp0=shm3+LDS_V+((lane>>4)&1)*32+(lane&3)*8+(4*hi+((lane&15)>>2))*64;
  DMA_K(0,0);DMA_V(0,0);DMA_K(1,SLOTB);
  bf16x8 qr[4];
  #pragma unroll
  for(int d0=0;d0<4;++d0)qr[d0]=*reinterpret_cast<const bf16x8*>(&Qw[(long)r32*QP+d0*16+hi*8]);
  float mhat=0.f,l_reg=0.f;f32x16 o[2];o[0]=f32x16{};o[1]=f32x16{};f32x16 negm=f32x16{};asm volatile("":"+v"(negm));
  #define CMASK(P0,P1,t) do{}while(0)
  bool resc=false;
  #define START(P0,P1) do{ const float rm=rowmax(P0,P1); resc=false; \
    { const float dl=rm; mhat=fadd_s(mhat,dl); \
      _Pragma("unroll") for(int r=0;r<16;++r){P0[r]=fsub_s(P0[r],dl);P1[r]=fsub_s(P1[r],dl);} \
      _Pragma("unroll") for(int r=0;r<16;++r)negm[r]=-mhat; asm volatile("":"+v"(negm)); } \
    _Pragma("unroll") for(int r=0;r<16;++r)P0[r]=__builtin_amdgcn_exp2f(P0[r]); }while(0)
  #define RESC() do{ if(resc){ asm volatile("s_waitcnt lgkmcnt(0)":::"memory"); \
      _Pragma("unroll") for(int d_=0;d_<2;++d_) _Pragma("unroll") for(int r=0;r<16;++r)o[d_][r]*=wsf[crow(r,hi)]; } }while(0)
  f32x16 pA0,pA1,pB0,pB1;
  int sl_prev=0,sl_cur=0,sl_next=SLOTB;
  #define ROT() do{sl_prev=sl_cur;sl_cur=sl_next;sl_next=(sl_next==(NSLOT-1)*SLOTB)?0:sl_next+SLOTB;}while(0)
  DMA_K(2,2*SLOTB);
  WAIT_BAR(3);
  qkt(pA0,pA1,Kbase,qr,negm,r32,hi);asm volatile("s_nop 15\n\ts_nop 7":"+v"(pA0),"+v"(pA1));CMASK(pA0,pA1,0);
  START(pA0,pA1);
  _Pragma("unroll") for(int r=0;r<16;++r)pA1[r]=__builtin_amdgcn_exp2f(pA1[r]);
  WAIT_BAR(0);
  DMA_K(3,0);DMA_V(1,SLOTB);
  ROT();
  kload8(kf,kp0+sl_cur);
  WAIT_BAR(2);
  s16x4 vlo[8],vhi[8]; u32x4 pw0,pw1,pw2,pw3;
  #define PKW(P,B) cvtpk_s(P[B],P[B+1])
  #define PAF(k) __builtin_bit_cast(bf16x8,pw##k)
  #define VFR(i) (bf16x8){vlo[i][0],vlo[i][1],vlo[i][2],vlo[i][3],vhi[i][0],vhi[i][1],vhi[i][2],vhi[i][3]}
  #define PIN(x) asm volatile("":"+v"(x))
  #define MX3(a,b,c) __builtin_fmaxf(__builtin_fmaxf((a),(b)),(c))
  #define GAPA(MF,A0,A1,A2,A3,W0,W1,PW) do{ MF; sacc+=A0; sacc+=A1; sacc+=A2; sacc+=A3; PIN(sacc); W0; W1; PIN(PW); SBAR(); }while(0)
  #define EX(v) __builtin_amdgcn_exp2f(v)
  #define GAPB(MF,X,B) do{ MF; X[B]=EX(X[B]); X[B+1]=EX(X[B+1]); X[B+2]=EX(X[B+2]); X[B+3]=EX(X[B+3]); PIN(X); SBAR(); }while(0)
  #define VRD(i) do{ vlo[i]=vtr(vp_+(((i)>>2)*4096+((i)&3)*1024)); vhi[i]=vtr(vp_+(((i)>>2)*4096+((i)&3)*1024+512)); }while(0)
  #define KRD(G,j) do{ if(G){ kload2(kf,kp0+sl_next,j); SBAR(); } }while(0)
  #define STEP(C0,C1,P0,P1,t,GK,GV,GL) do{ SBAR(); \
    const lds_cptr vp_=vp0+sl_prev; \
    VRD(0); SBAR(); float sacc=(P0[0]+P0[1]); \
    GAPA(C0=__builtin_amdgcn_mfma_f32_32x32x16_bf16(kf[0],qr[0],negm,0,0,0), P0[2],P0[3],P0[4],P0[5],     pw0[0]=PKW(P0,0), pw0[1]=PKW(P0,2), pw0); \
    VRD(4); SBAR(); GAPA(C1=__builtin_amdgcn_mfma_f32_32x32x16_bf16(kf[1],qr[0],negm,0,0,0), P0[6],P0[7],P0[8],P0[9],     pw0[2]=PKW(P0,4), pw0[3]=PKW(P0,6), pw0); \
    VRD(1); SBAR(); GAPA(C0=__builtin_amdgcn_mfma_f32_32x32x16_bf16(kf[2],qr[1],C0,0,0,0),   P0[10],P0[11],P0[12],P0[13], pw1[0]=PKW(P0,8), pw1[1]=PKW(P0,10), pw1); \
    VRD(5); SBAR(); GAPA(C1=__builtin_amdgcn_mfma_f32_32x32x16_bf16(kf[3],qr[1],C1,0,0,0),   P0[14],P0[15],P1[0],P1[1],   pw1[2]=PKW(P0,12),pw1[3]=PKW(P0,14), pw1); \
    VRD(2); SBAR(); GAPA(C0=__builtin_amdgcn_mfma_f32_32x32x16_bf16(kf[4],qr[2],C0,0,0,0),   P1[2],P1[3],P1[4],P1[5],     pw2[0]=PKW(P1,0), pw2[1]=PKW(P1,2), pw2); \
    VRD(6); SBAR(); GAPA(C1=__builtin_amdgcn_mfma_f32_32x32x16_bf16(kf[5],qr[2],C1,0,0,0),   P1[6],P1[7],P1[8],P1[9],     pw2[2]=PKW(P1,4), pw2[3]=PKW(P1,6), pw2); \
    VRD(3); SBAR(); GAPA(C0=__builtin_amdgcn_mfma_f32_32x32x16_bf16(kf[6],qr[3],C0,0,0,0),   P1[10],P1[11],P1[12],P1[13], pw3[0]=PKW(P1,8), pw3[1]=PKW(P1,10), pw3); \
    VRD(7); SBAR(); GAPA(C1=__builtin_amdgcn_mfma_f32_32x32x16_bf16(kf[7],qr[3],C1,0,0,0),   P1[14],P1[15],0.f,0.f,       pw3[2]=PKW(P1,12),pw3[3]=PKW(P1,14), pw3); \
    l_reg+=sacc; \
    if(GK){DMA_K((t)+3,sl_cur);} if(GV){DMA_V((t)+1,sl_next);} \
    CMASK(C0,C1,t); \
    { float a=MX3(C0[0],C0[1],C1[0]),b=MX3(C0[2],C0[3],C1[1]); a=MX3(a,C1[2],C1[3]); \
      _Pragma("unroll") for(int r=4;r<16;r+=4){a=MX3(a,C0[r],C0[r+1]);b=MX3(b,C0[r+2],C0[r+3]);a=MX3(a,C1[r],C1[r+1]);b=MX3(b,C1[r+2],C1[r+3]);} \
      float rm=__builtin_fmaxf(a,b); { auto rr=__builtin_amdgcn_permlane32_swap(__float_as_uint(rm),__float_as_uint(rm),false,false); rm=__builtin_fmaxf(__uint_as_float(rr[0]),__uint_as_float(rr[1])); } \
      resc=false; \
      if(__builtin_expect(__any(rm>(float)THRL),0)){ const float dl=__builtin_fmaxf(rm,0.f); mhat+=dl; \
        _Pragma("unroll") for(int r=0;r<16;++r){C0[r]-=dl;C1[r]-=dl;} \
        _Pragma("unroll") for(int r=0;r<16;++r)negm[r]=-mhat; asm volatile("":"+v"(negm)); \
        const float f=__builtin_amdgcn_exp2f(-dl); l_reg*=f; if(hi==0)wsf[r32]=f; resc=true; } } \
    SBAR(); \
    GAPB(o[0]=__builtin_amdgcn_mfma_f32_32x32x16_bf16(PAF(0),VFR(0),o[0],0,0,0), C0,0); \
    GAPB(o[1]=__builtin_amdgcn_mfma_f32_32x32x16_bf16(PAF(0),VFR(4),o[1],0,0,0), C0,4); \
    KRD(GL,0); GAPB(o[0]=__builtin_amdgcn_mfma_f32_32x32x16_bf16(PAF(1),VFR(1),o[0],0,0,0), C0,8); \
    KRD(GL,1); GAPB(o[1]=__builtin_amdgcn_mfma_f32_32x32x16_bf16(PAF(1),VFR(5),o[1],0,0,0), C0,12); \
    KRD(GL,2); GAPB(o[0]=__builtin_amdgcn_mfma_f32_32x32x16_bf16(PAF(2),VFR(2),o[0],0,0,0), C1,0); \
    KRD(GL,3); GAPB(o[1]=__builtin_amdgcn_mfma_f32_32x32x16_bf16(PAF(2),VFR(6),o[1],0,0,0), C1,4); \
    GAPB(o[0]=__builtin_amdgcn_mfma_f32_32x32x16_bf16(PAF(3),VFR(3),o[0],0,0,0), C1,8); \
    GAPB(o[1]=__builtin_amdgcn_mfma_f32_32x32x16_bf16(PAF(3),VFR(7),o[1],0,0,0), C1,12); \
    }while(0)
  int t=1;
  #undef CMASK
  #define CMASK(P0,P1,t) do{}while(0)
  for(;t+5<NT;t+=2){
    STEP(pB0,pB1,pA0,pA1,t,true,true,true);     WAIT_BAR(2); RESC(); ROT();
    STEP(pA0,pA1,pB0,pB1,t+1,true,true,true);   WAIT_BAR(2); RESC(); ROT();
  }
  #undef CMASK
  #define CMASK(P0,P1,t) do{}while(0)
  #define ENDW(tt) do{ if((tt)+3<NT){WAIT_BAR(2);} else if((tt)+2<NT){WAIT_BAR(1);} else {WAIT_BAR(0);} }while(0)
  for(;t+1<NT;t+=2){
    STEP(pB0,pB1,pA0,pA1,t,(t+3<NT),(t+1<NT),(t+1<NT));       ENDW(t);   RESC(); ROT();
    STEP(pA0,pA1,pB0,pB1,t+1,(t+4<NT),(t+2<NT),(t+2<NT));     ENDW(t+1); RESC(); ROT();
  }
  STEP(pB0,pB1,pA0,pA1,NT-1,false,false,false); RESC();
  { float sacc=pB0[0]+pB0[1]; _Pragma("unroll") for(int r=2;r<16;++r)sacc+=pB0[r]; _Pragma("unroll") for(int r=0;r<16;++r)sacc+=pB1[r]; l_reg+=sacc;
    pw0=(u32x4){PKW(pB0,0),PKW(pB0,2),PKW(pB0,4),PKW(pB0,6)};pw1=(u32x4){PKW(pB0,8),PKW(pB0,10),PKW(pB0,12),PKW(pB0,14)};pw2=(u32x4){PKW(pB1,0),PKW(pB1,2),PKW(pB1,4),PKW(pB1,6)};pw3=(u32x4){PKW(pB1,8),PKW(pB1,10),PKW(pB1,12),PKW(pB1,14)};
    SBAR(); pv(o,vb0+sl_cur,PAF(0),PAF(1),PAF(2),PAF(3)); }
  #undef PKW
  #undef PAF
  #undef VFR
  #undef PIN
  #undef MX3
  #undef GAPA
  #undef GAPB
  #undef EX
  #undef VRD
  #undef KRD
  #undef STEP
  #undef ENDW
  {auto rr=__builtin_amdgcn_permlane32_swap(__float_as_uint(l_reg),__float_as_uint(l_reg),false,false);l_reg=__uint_as_float(rr[0])+__uint_as_float(rr[1]);}
  if(hi==0)wsf[32+r32]=l_reg;asm volatile("s_waitcnt lgkmcnt(0)":::"memory");
  float rli[16];
  #pragma unroll
  for(int r=0;r<16;++r)rli[r]=__builtin_amdgcn_rcpf(wsf[32+crow(r,hi)]);
  bf16*Ow=Ou+(long)(wid*QBLK)*OP;
  { bf16*stg=(bf16*)(shm+LDS_OST)+wid*2048;
    #pragma unroll
    for(int r=0;r<16;++r){const int orow=crow(r,hi);
      #pragma unroll
      for(int d0=0;d0<2;++d0)stg[orow*64+d0*32+r32]=__float2bfloat16(o[d0][r]*rli[r]);}
    asm volatile("s_waitcnt lgkmcnt(0)":::"memory");
    #pragma unroll
    for(int i=0;i<4;++i){const int row=i*8+(lane>>3),ch=lane&7; const u32x4 v=*(const u32x4*)(stg+row*64+ch*8); ATTN_STORE16(Ow+(long)row*OP+ch*8,v);} }
  asm volatile("s_waitcnt lgkmcnt(0)\n\ts_barrier":::"memory");
  #undef DMA_K
  #undef DMA_V
  #undef CMASK
  #undef START
  #undef RESC
  #undef ROT
}
constexpr int ATTN_LDS_BYTES=LDS_BYTES;
#undef SBAR
#undef WAIT_BAR
}
namespace dil {
using bf16x8 = __attribute__((ext_vector_type(8))) short;
using s16x4 = __attribute__((ext_vector_type(4))) short;
using f32x16 = __attribute__((ext_vector_type(16))) float;
using u32x4 = __attribute__((ext_vector_type(4))) unsigned;
typedef unsigned short bf16_t;
#define DLAS __attribute__((address_space(3)))
constexpr int VPITCH = 144, VBUF = 32 * VPITCH, WAVE_LDS = 2 * VBUF;
__device__ __forceinline__ int crow(int r, int hi) { return (r & 3) + 8 * (r >> 2) + 4 * hi; }
typedef float f32x2c_t __attribute__((ext_vector_type(2))); typedef __bf16 bf16x2c_t __attribute__((ext_vector_type(2)));
__device__ __forceinline__ unsigned cvtpk(float lo, float hi) { f32x2c_t v = {lo, hi}; bf16x2c_t b = __builtin_convertvector(v, bf16x2c_t); return __builtin_bit_cast(unsigned, b); }
__device__ __forceinline__ void dil_task(int task, const bf16_t* __restrict__ QB, const bf16_t* __restrict__ KB, const bf16_t* __restrict__ VB, bf16_t* OBP, float* LSE, DLAS char* vbuf, int lane) {
    const int r32 = lane & 31, hi = lane >> 5;
    const int h = task & 3, rbg = task >> 2, g = rbg / 1536, rb = rbg - g * 1536, sh = 2 * g, rowp0 = rb * 32;
    int seqbase, lgS; if (rowp0 < MPROMPT) { lgS = 12; seqbase = rowp0 & ~4095; } else { lgS = 11; seqbase = MPROMPT + ((rowp0 - MPROMPT) & ~2047); }
    const int lgL = lgS - sh, L = 1 << lgL, tl = rowp0 - seqbase, rho = tl >> lgL, u0 = tl & (L - 1), segbase = rowp0 - u0;
    const size_t goff = (size_t)g * MTOK * 256;
    const bf16_t* Qp = QB + goff + (size_t)(rowp0 + r32) * 256 + h * 64 + hi * 8;
    bf16x8 qf[4];
#pragma unroll
    for (int d0 = 0; d0 < 4; ++d0) qf[d0] = *(const bf16x8*)(Qp + d0 * 16);
    f32x16 p[5];
#pragma unroll
    for (int j = 0; j < 5; ++j) { int uu = u0 - 64 + 32 * j + r32; uu = uu < 0 ? 0 : (uu > L - 1 ? L - 1 : uu);
        const bf16_t* Kp = KB + goff + (size_t)(segbase + uu) * 256 + h * 64 + hi * 8;
        f32x16 a = f32x16{};
#pragma unroll
        for (int d0 = 0; d0 < 4; ++d0) a = __builtin_amdgcn_mfma_f32_32x32x16_bf16(*(const bf16x8*)(Kp + d0 * 16), qf[d0], a, 0, 0, 0);
        p[j] = a; }
#define DIL_VLOAD(dst, j) do { _Pragma("unroll") for (int i = 0; i < 4; ++i) { const int c = lane + 64 * i, kk = c >> 3, ch = c & 7; int uu = u0 - 64 + 32 * (j) + kk; uu = uu < 0 ? 0 : (uu > L - 1 ? L - 1 : uu); \
        dst[i] = *(const u32x4*)(VB + goff + (size_t)(segbase + uu) * 256 + h * 64 + ch * 8); } } while (0)
    u32x4 vreg[2][4];
    DIL_VLOAD(vreg[0], 0); DIL_VLOAD(vreg[1], 1);
    float mx = -INFINITY;
#pragma unroll
    for (int j = 0; j < 5; ++j)
#pragma unroll
        for (int r = 0; r < 16; ++r) { const int rel = 32 * j - 64 + crow(r, hi) - r32, uk = u0 + r32 + rel;
            const bool valid = (rel >= -64) && (rel <= 64) && (uk >= 0) && (uk < L);
            const float s = valid ? p[j][r] : -INFINITY; p[j][r] = s; mx = fmaxf(mx, s); }
    mx = fmaxf(mx, __shfl_xor(mx, 32));
    float l = 0.f;
#pragma unroll
    for (int j = 0; j < 5; ++j)
#pragma unroll
        for (int r = 0; r < 16; ++r) { const float e = __builtin_amdgcn_exp2f(p[j][r] - mx); p[j][r] = e; l += e; }
    l += __shfl_xor(l, 32);
    f32x16 o[2]; o[0] = f32x16{}; o[1] = f32x16{};
    const unsigned vb0 = (unsigned)(uintptr_t)vbuf + (unsigned)((4 * hi + ((lane & 15) >> 2)) * VPITCH + ((lane >> 4) & 1) * 32 + (lane & 3) * 8);
#pragma unroll
    for (int j = 0; j < 5; ++j) { DLAS char* buf = vbuf + (j & 1) * VBUF; const unsigned vb = vb0 + (unsigned)((j & 1) * VBUF);
#pragma unroll
        for (int i = 0; i < 4; ++i) { const int c = lane + 64 * i, kk = c >> 3, ch = c & 7; *(DLAS u32x4*)(buf + kk * VPITCH + ch * 16) = vreg[j & 1][i]; }
        if (j + 2 < 5) DIL_VLOAD(vreg[j & 1], j + 2);
        asm volatile("s_waitcnt lgkmcnt(0)" ::: "memory");
        s16x4 lo[2][2], hh[2][2];
#pragma unroll
        for (int ks = 0; ks < 2; ++ks)
#pragma unroll
            for (int db = 0; db < 2; ++db) {
                asm volatile("ds_read_b64_tr_b16 %0, %1 offset:%c2" : "=&v"(lo[ks][db]) : "v"(vb), "i"(ks * 16 * VPITCH + db * 64) : "memory");
                asm volatile("ds_read_b64_tr_b16 %0, %1 offset:%c2" : "=&v"(hh[ks][db]) : "v"(vb), "i"(ks * 16 * VPITCH + db * 64 + 8 * VPITCH) : "memory"); }
        asm volatile("s_waitcnt lgkmcnt(0)" ::: "memory"); __builtin_amdgcn_sched_barrier(0);
#pragma unroll
        for (int ks = 0; ks < 2; ++ks) { u32x4 pw; pw.x = cvtpk(p[j][8 * ks + 0], p[j][8 * ks + 1]); pw.y = cvtpk(p[j][8 * ks + 2], p[j][8 * ks + 3]); pw.z = cvtpk(p[j][8 * ks + 4], p[j][8 * ks + 5]); pw.w = cvtpk(p[j][8 * ks + 6], p[j][8 * ks + 7]);
            const bf16x8 pa = __builtin_bit_cast(bf16x8, pw);
#pragma unroll
            for (int db = 0; db < 2; ++db) { const bf16x8 vf = (bf16x8){lo[ks][db][0], lo[ks][db][1], lo[ks][db][2], lo[ks][db][3], hh[ks][db][0], hh[ks][db][1], hh[ks][db][2], hh[ks][db][3]};
                o[db] = __builtin_amdgcn_mfma_f32_32x32x16_bf16(pa, vf, o[db], 0, 0, 0); } }
    }
    const float linv = 1.0f / l, lse2 = mx + __builtin_amdgcn_logf(l);
#pragma unroll
    for (int r = 0; r < 16; ++r) { const int q = crow(r, hi); const float rl = __shfl(linv, q); const size_t row = (size_t)(seqbase + rho + ((u0 + q) << sh));
        bf16_t* op = OBP + goff + row * 256 + h * 64 + r32;
        op[0] = (bf16_t)(cvtpk(o[0][r] * rl, 0.f) & 0xffffu); op[32] = (bf16_t)(cvtpk(o[1][r] * rl, 0.f) & 0xffffu); }
    if (hi == 0) LSE[((size_t)g * MTOK + (size_t)(seqbase + rho + ((u0 + r32) << sh))) * 4 + h] = lse2;
}
#undef DIL_VLOAD
}

constexpr size_t MiB = 1u << 20;
constexpr size_t WS_GN = 1 * MiB - 4096, WS_T1 = 1 * MiB, WS_T2 = 1 * MiB + 65536, WS_SS1 = 2 * MiB, WS_SS2 = 5 * MiB, WS_LSE = 8 * MiB;
constexpr size_t WS_WUP = 12 * MiB, WS_WDN = 20 * MiB;
constexpr size_t WS_U = 28 * MiB, WS_H2 = 412 * MiB, WS_END = 508 * MiB;
constexpr size_t WS_W1 = 28 * MiB, WS_WA = 38 * MiB, WS_WB = 39 * MiB, WS_WO = 40 * MiB;
constexpr size_t WS_H1 = 44 * MiB, WS_OBP = 44 * MiB, WS_OB = 116 * MiB;
constexpr size_t WS_QA = 140 * MiB, WS_KA = 188 * MiB, WS_VA = 200 * MiB, WS_QB = 212 * MiB, WS_KB = 284 * MiB, WS_VB = 356 * MiB, WS_OA = 428 * MiB;
constexpr size_t WS_MIX = 212 * MiB;
constexpr int LDS_BYTES = 147456, NWAVES = 8;
#define LAS __attribute__((address_space(3)))
typedef unsigned short bf16;
typedef unsigned v4u __attribute__((ext_vector_type(4)));
typedef float f32x4 __attribute__((ext_vector_type(4)));
__device__ __forceinline__ unsigned f2bf(float f) { unsigned u = __builtin_bit_cast(unsigned, f); return (u + 0x7fffu + ((u >> 16) & 1u)) >> 16; }
__device__ __forceinline__ unsigned pk2(float lo, float hi) { return f2bf(lo) | (f2bf(hi) << 16); }
__device__ __forceinline__ float wave_sum(float v) {
#pragma unroll
    for (int o = 1; o < 64; o <<= 1) v += __shfl_xor(v, o);
    return v;
}
__device__ __forceinline__ void p0_transpose_item(const float* W, int K, int N, bf16* WT, int k0, int n0, int orow0, LAS float* scr, int lane) {
#pragma unroll 8
    for (int i = 0; i < 32; ++i) { const int kk = 2 * i + (lane >> 5); scr[kk * 33 + (lane & 31)] = W[(size_t)(k0 + kk) * N + n0 + (lane & 31)]; }
    asm volatile("s_waitcnt lgkmcnt(0)" ::: "memory");
    const int c = lane & 7;
#pragma unroll
    for (int j = 0; j < 4; ++j) { const int n = (lane >> 3) + 8 * j; const LAS float* s = scr + (8 * c) * 33 + n;
        v4u o; o.x = pk2(s[0 * 33], s[1 * 33]); o.y = pk2(s[2 * 33], s[3 * 33]); o.z = pk2(s[4 * 33], s[5 * 33]); o.w = pk2(s[6 * 33], s[7 * 33]);
        *(v4u*)(WT + (size_t)(orow0 + n) * K + k0 + 8 * c) = o; }
    asm volatile("s_waitcnt lgkmcnt(0)" ::: "memory");
}
__device__ __forceinline__ void transpose_matrix(const float* W, int K, int N, bf16* WT, bool perm, LAS float* scr, int lane, int gw, int NGW) {
    const int nblk = N / 32, nitems = (K / 64) * nblk;
    for (int it = gw; it < nitems; it += NGW) { const int kb = it / nblk, nb = it - kb * nblk, n0 = 32 * nb; int orow0 = n0;
        if (perm && n0 < 3072) { const int nl = n0 & 255; orow0 = (n0 & ~255) + 128 * ((nl >> 5) & 1) + 32 * (nl >> 6); }
        p0_transpose_item(W, K, N, WT, 64 * kb, n0, orow0, scr, lane); }
}

struct Args { const float* in[13]; float* out; unsigned char* ws; };
__global__ void __launch_bounds__(NWAVES * 64, 2) fwd_megakernel(Args args) {
    extern __shared__ __attribute__((aligned(16))) unsigned char lds[];
    cg::grid_group grid = cg::this_grid();
    LAS unsigned char* ldsl = (LAS unsigned char*)lds;
#define GEOM() int tid_l = threadIdx.x; asm volatile("" : "+v"(tid_l)); const int tid = tid_l, lane = tid & 63, wave = __builtin_amdgcn_readfirstlane(tid >> 6); (void)lane; const int G = gridDim.x, bx = blockIdx.x, vcu = (G % 8 == 0) ? (bx % 8) * (G / 8) + bx / 8 : bx, gw = vcu * NWAVES + wave, NGW = G * NWAVES; (void)vcu; (void)gw; (void)NGW
#define WSP(T, off) ((T*)(args.ws + (off)))
#define GRID_SYNC() do { ++sync_no; __builtin_amdgcn_fence(__ATOMIC_RELEASE, "agent"); asm volatile("s_waitcnt vmcnt(0) lgkmcnt(0)" ::: "memory"); __syncthreads(); \
    if (threadIdx.x == 0) { unsigned* ctr_ = (unsigned*)args.ws; __hip_atomic_fetch_add(ctr_, 1u, __ATOMIC_RELAXED, __HIP_MEMORY_SCOPE_AGENT); const unsigned want_ = sync_no * gridDim.x; \
        while (__hip_atomic_load(ctr_, __ATOMIC_RELAXED, __HIP_MEMORY_SCOPE_AGENT) < want_) __builtin_amdgcn_s_sleep(2); } \
    __syncthreads(); __builtin_amdgcn_fence(__ATOMIC_ACQUIRE, "agent"); asm volatile("s_waitcnt vmcnt(0)" ::: "memory"); } while (0)

#ifdef DIAG_STAGE
#define DIAG_DUMP(k, expr) if (DIAG_STAGE == (k)) { const bf16* Q_ = WSP(bf16, 0); (void)Q_; for (size_t idx = (size_t)blockIdx.x * 512 + threadIdx.x; idx < (size_t)MTOK * 1024; idx += (size_t)gridDim.x * 512) { const size_t row = idx >> 10; const int c = (int)(idx & 1023); (void)row; (void)c; const unsigned short hv_ = (expr); args.out[idx] = __uint_as_float((unsigned)hv_ << 16); } return; }
#define DIAG_RET(k) if (DIAG_STAGE == (k)) return;
#else
#define DIAG_DUMP(k, expr)
#define DIAG_RET(k)
#endif
    unsigned sync_no = 0u;
    grid.sync();

#ifdef DIAG_ZERO
    { for (int i = threadIdx.x; i < LDS_BYTES / 4; i += NWAVES * 64) ((LAS unsigned*)ldsl)[i] = 0u; __syncthreads(); }
#endif
    {
        GEOM();
        LAS float* scr = (LAS float*)(ldsl + wave * 16384);
        transpose_matrix(args.in[2], 1024, 5120, WSP(bf16, WS_W1), true, scr, lane, gw, NGW);
        transpose_matrix(args.in[3], 512, 1024, WSP(bf16, WS_WA), false, scr, lane, gw, NGW);
        transpose_matrix(args.in[4], 256, 1024, WSP(bf16, WS_WB), false, scr, lane, gw, NGW);
        transpose_matrix(args.in[5], 1024, 1024, WSP(bf16, WS_WO), false, scr, lane, gw, NGW);
        transpose_matrix(args.in[10], 1024, 4096, WSP(bf16, WS_WUP), false, scr, lane, gw, NGW);
        transpose_matrix(args.in[11], 4096, 1024, WSP(bf16, WS_WDN), false, scr, lane, gw, NGW);
        float* T1 = WSP(float, WS_T1); float* T2 = WSP(float, WS_T2); float* GN = WSP(float, WS_GN);
        const int gt = bx * (NWAVES * 64) + tid, NT_ = G * NWAVES * 64;
        for (int i = gt; i < 64 * 16 + 4096 * 8 + 128; i += NT_) {
            if (i < 1024) { const int pos = i >> 4, k = i & 15; const float fr = (float)pow(10000.0, -(double)k / 16.0); const float ang = (float)pos * fr;
                T1[2 * i] = (float)cos((double)ang); T1[2 * i + 1] = (float)sin((double)ang); }
            else if (i < 1024 + 32768) { const int j = i - 1024, pos = j >> 3, k = j & 7; const float fr = (float)pow(500000.0, -(double)k / 8.0); const float ang = (float)pos * fr;
                T2[2 * j] = (float)cos((double)ang); T2[2 * j + 1] = (float)sin((double)ang); }
            else { const int j = i - 1024 - 32768; GN[j] = j < 64 ? args.in[7][j] : args.in[8][j - 64]; }
        }
        const float *xp = args.in[0], *xs = args.in[1], *g_mix = args.in[6]; bf16* H1 = WSP(bf16, WS_H1);
        for (int m = gw; m < MTOK; m += NGW) {
            const float* xrow = m < MPROMPT ? xp + (size_t)m * 1024 : xs + (size_t)(m - MPROMPT) * 1024;
            const f32x4* xr = (const f32x4*)xrow + lane; const f32x4* gr = (const f32x4*)g_mix + lane;
            f32x4 v[4]; float s = 0.f;
#pragma unroll
            for (int j = 0; j < 4; ++j) { v[j] = xr[64 * j]; s += (v[j].x * v[j].x + v[j].y * v[j].y) + (v[j].z * v[j].z + v[j].w * v[j].w); }
            const float rinv = 1.0f / sqrtf(wave_sum(s) * (1.0f / 1024.0f) + RMS_EPS);
            unsigned long long* o8 = (unsigned long long*)(H1 + (size_t)m * 1024) + lane;
#pragma unroll
            for (int j = 0; j < 4; ++j) { const f32x4 gq = gr[64 * j]; o8[64 * j] = (unsigned long long)pk2(v[j].x * rinv * gq.x, v[j].y * rinv * gq.y) | ((unsigned long long)pk2(v[j].z * rinv * gq.z, v[j].w * rinv * gq.w) << 32); }
        }
    }
    GRID_SYNC();
    {
        GEOM();
        pg8::Gemm g{WSP(bf16, WS_H1), WSP(bf16, WS_W1), MTOK, 5120, 1024}; pg8::StaticOrder S; S.init(MTOK, 5120, G, bx);
        pg8::Epi1 E{WSP(bf16, WS_QA), WSP(bf16, WS_QB), (bf16*)args.out, WSP(float, WS_GN), WSP(float, WS_T1), WSP(float, WS_T2)};
        pg8::gemm_phase<pg8::Epi1, pg8::StaticOrder, true, true>(ldsl, g, S, E);
    }
    GRID_SYNC();
    DIAG_DUMP(1, c < 512 ? Q_[WS_QA / 2 + row * 512 + c] : c < 640 ? Q_[WS_KA / 2 + row * 128 + c - 512] : c < 768 ? Q_[WS_VA / 2 + row * 128 + c - 640] : Q_[WS_QB / 2 + row * 256 + c - 768])
    DIAG_DUMP(11, c < 256 ? Q_[WS_KB / 2 + row * 256 + c] : c < 512 ? Q_[WS_VB / 2 + row * 256 + c - 256] : c < 768 ? Q_[WS_KB / 2 + (size_t)2 * MTOK * 256 + row * 256 + c - 512] : Q_[WS_VB / 2 + (size_t)2 * MTOK * 256 + row * 256 + c - 768])
    DIAG_DUMP(12, ((const bf16*)args.out)[(idx >> 1) + ((idx & 1) ? (size_t)MTOK * 512 : 0)])
    {
        GEOM();
        LAS char* vbuf = (LAS char*)ldsl + wave * dil::WAVE_LDS;
        for (int task = gw; task < 3 * 1536 * 4; task += NGW) dil::dil_task(task, WSP(bf16, WS_QB), WSP(bf16, WS_KB), WSP(bf16, WS_VB), WSP(bf16, WS_OBP), WSP(float, WS_LSE), vbuf, lane);
    }
    GRID_SYNC();
    DIAG_DUMP(2, c < 768 ? Q_[WS_OBP / 2 + (size_t)(c >> 8) * MTOK * 256 + row * 256 + (c & 255)] : (unsigned short)(((const unsigned*)WSP(float, WS_LSE))[((size_t)((c - 768) >> 2) % 3 * MTOK + row) * 4 + (c & 3)] >> 16))
    {
        GEOM();
        {
        const float* LSE = WSP(float, WS_LSE); const bf16* OBP = WSP(bf16, WS_OBP); bf16* OB = WSP(bf16, WS_OB);
        const int gt = bx * (NWAVES * 64) + tid, NT_ = G * NWAVES * 64;
        for (int idx = gt; idx < MTOK * 32; idx += NT_) { const int row = idx >> 5, ch = idx & 31, h = ch >> 3;
            const float l0 = LSE[((size_t)row) * 4 + h], l1 = LSE[((size_t)MTOK + row) * 4 + h], l2 = LSE[((size_t)2 * MTOK + row) * 4 + h];
            const float mx = fmaxf(l0, fmaxf(l1, l2)); float w0 = __builtin_amdgcn_exp2f(l0 - mx), w1 = __builtin_amdgcn_exp2f(l1 - mx), w2 = __builtin_amdgcn_exp2f(l2 - mx);
            const float inv = 1.0f / (w0 + w1 + w2); w0 *= inv; w1 *= inv; w2 *= inv;
            float a[8], b[8], c[8], o[8]; pg8::ld8(OBP + (size_t)row * 256 + ch * 8, a); pg8::ld8(OBP + ((size_t)MTOK + row) * 256 + ch * 8, b); pg8::ld8(OBP + ((size_t)2 * MTOK + row) * 256 + ch * 8, c);
#pragma unroll
            for (int e = 0; e < 8; ++e) o[e] = w0 * a[e] + w1 * b[e] + w2 * c[e];
            pg8::st8(OB + (size_t)row * 256 + ch * 8, o); }
        }
        __syncthreads();
        const attn_body::bf16* QA = WSP(const attn_body::bf16, WS_QA); const attn_body::bf16* KA = WSP(const attn_body::bf16, WS_KA); const attn_body::bf16* VA = WSP(const attn_body::bf16, WS_VA); attn_body::bf16* OA = WSP(attn_body::bf16, WS_OA);
        for (int vv = vcu; vv < 256; vv += G) {
            for (int i = 0; i < 6; ++i) {
                int b, h, qb, nt; size_t rb;
                if (i < 2) { const int id = 2 * vv + i; b = id >> 7; h = (id >> 4) & 7; qb = id & 15; rb = (size_t)b * 4096; nt = 64; }
                else { const int id = 4 * vv + (i - 2); b = id >> 6; h = (id >> 3) & 7; qb = id & 7; rb = (size_t)MPROMPT + (size_t)b * 2048; nt = 32; }
                attn_body::attn_unit<8>(QA + (rb + qb * 256) * 512 + h * 64, KA + rb * 128 + (h >> 2) * 64, VA + rb * 128 + (h >> 2) * 64, OA + (rb + qb * 256) * 512 + h * 64, nt, (char*)lds);
            }
        }
    }
    GRID_SYNC();
    DIAG_DUMP(3, c < 512 ? Q_[WS_OA / 2 + row * 512 + c] : c < 768 ? Q_[WS_OB / 2 + row * 256 + c - 512] : (unsigned short)0)
    {
        GEOM();
        pg8::Gemm g{WSP(bf16, WS_OA), WSP(bf16, WS_WA), MTOK, 1024, 512}; pg8::StaticOrder S; S.init(MTOK, 1024, G, bx);
        pg8::Epi3a E{(const bf16*)args.out, WSP(bf16, WS_MIX)};
        pg8::gemm_phase<pg8::Epi3a, pg8::StaticOrder, true, true>(ldsl, g, S, E);
    }
    __syncthreads();
    {
        GEOM();
        pg8::Gemm g{WSP(bf16, WS_OB), WSP(bf16, WS_WB), MTOK, 1024, 256}; pg8::StaticOrder S; S.init(MTOK, 1024, G, bx);
        pg8::Epi3b E{(const bf16*)args.out + (size_t)MTOK * 1024, WSP(bf16, WS_MIX)};
        pg8::gemm_phase<pg8::Epi3b, pg8::StaticOrder, true, true>(ldsl, g, S, E);
    }
    GRID_SYNC();
    DIAG_DUMP(4, Q_[WS_MIX / 2 + row * 1024 + c])
    {
        GEOM();
        pg8::Gemm g{WSP(bf16, WS_MIX), WSP(bf16, WS_WO), MTOK, 1024, 1024}; pg8::StaticOrder S; S.init(MTOK, 1024, G, bx);
        pg8::Epi4 E{args.in[0], (long long)((const char*)args.in[1] - (const char*)args.in[0]) - (long long)MPROMPT * 4096, args.out, WSP(bf16, WS_H2), args.in[9], WSP(float, WS_SS1)};
        pg8::gemm_phase<pg8::Epi4, pg8::StaticOrder, true, true>(ldsl, g, S, E);
    }
    GRID_SYNC();
    DIAG_RET(5)
    {
        GEOM();
        pg8::Gemm g{WSP(bf16, WS_H2), WSP(bf16, WS_WUP), MTOK, 4096, 1024}; pg8::StaticOrder S; S.init(MTOK, 4096, G, bx);
        pg8::Epi5 E{WSP(bf16, WS_U), WSP(float, WS_SS1)};
        pg8::gemm_phase<pg8::Epi5, pg8::StaticOrder, true, true>(ldsl, g, S, E);
    }
    GRID_SYNC();
    DIAG_DUMP(6, Q_[WS_U / 2 + row * 4096 + c])
    {
        GEOM();
        pg8::Gemm g{WSP(bf16, WS_U), WSP(bf16, WS_WDN), MTOK, 1024, 4096}; pg8::StaticOrder S; S.init(MTOK, 1024, G, bx);
        pg8::Epi6 E{args.out, WSP(float, WS_SS2)};
        pg8::gemm_phase<pg8::Epi6, pg8::StaticOrder, true, true>(ldsl, g, S, E);
    }
    GRID_SYNC();
    DIAG_RET(7)
    {
        GEOM();
        float* out = args.out; const float* SS2 = WSP(float, WS_SS2); const float* g_fin = args.in[12];
        for (int m = gw; m < MTOK; m += NGW) {
            f32x4* xr = (f32x4*)(out + (size_t)m * 1024) + lane; const f32x4* gr = (const f32x4*)g_fin + lane;
            float s = lane < 16 ? SS2[(size_t)m * 16 + lane] : 0.f;
            const float rinv = 1.0f / sqrtf(wave_sum(s) * (1.0f / 1024.0f) + RMS_EPS);
#pragma unroll
            for (int j = 0; j < 4; ++j) { const f32x4 v = xr[64 * j], gq = gr[64 * j]; xr[64 * j] = v * rinv * gq; }
        }
    }
}

extern "C" void kernel_launch(void* const* d_in, const int* in_sizes, int n_in, void* d_out, int out_size, void* d_ws, size_t ws_size, hipStream_t stream) {
    static int grid = 0;
    if (grid == 0) {
        if (n_in != 13 || out_size != MTOK * 1024 || ws_size < WS_END) { fprintf(stderr, "kernel_launch: unexpected shapes (n_in %d, out %d, ws %zu)\n", n_in, out_size, ws_size); grid = -1; return; }
        int dev = 0, cus = 0, per_cu = 0;
        (void)hipGetDevice(&dev); (void)hipDeviceGetAttribute(&cus, hipDeviceAttributeMultiprocessorCount, dev);
        if (hipFuncSetAttribute((const void*)fwd_megakernel, hipFuncAttributeMaxDynamicSharedMemorySize, LDS_BYTES) != hipSuccess) { fprintf(stderr, "kernel_launch: hipFuncSetAttribute failed\n"); grid = -1; return; }
        if (hipOccupancyMaxActiveBlocksPerMultiprocessor(&per_cu, (const void*)fwd_megakernel, NWAVES * 64, LDS_BYTES) != hipSuccess || per_cu < 1) { fprintf(stderr, "kernel_launch: occupancy query says %d blocks per CU\n", per_cu); (void)hipGetLastError(); grid = -1; return; }
        grid = cus;
        if (grid > 256) grid = 256;
    }
    if (grid < 0) return;
    (void)hipMemsetAsync(d_ws, 0, 4096, stream);
    Args a{};
    for (int i = 0; i < 13; ++i) a.in[i] = (const float*)d_in[i];
    a.out = (float*)d_out; a.ws = (unsigned char*)d_ws;
    void* kargs[] = {&a};
    hipError_t e = hipLaunchCooperativeKernel((const void*)fwd_megakernel, dim3(grid), dim3(NWAVES * 64), kargs, LDS_BYTES, stream);
    if (e != hipSuccess) fprintf(stderr, "kernel_launch: cooperative launch failed: %s (grid %d)\n", hipGetErrorString(e), grid);
}
```

```cpp
#include <hip/hip_runtime.h>
#include <hip/hip_cooperative_groups.h>
#include <hip/hip_bf16.h>
#include <cstdio>
#include <cstdint>
#include <cmath>
namespace cg = cooperative_groups;
constexpr int MTOK = 49152, MPROMPT = 16384;
constexpr float RMS_EPS = 1e-6f;
constexpr float QSCALE = 0.125f * 1.4426950408889634f;
namespace pg8 {
#define PG8_LAS __attribute__((address_space(3)))
typedef unsigned short bf16_t;
typedef short bf16x8 __attribute__((ext_vector_type(8)));
typedef float f32x4 __attribute__((ext_vector_type(4)));
typedef unsigned u32x4 __attribute__((ext_vector_type(4)));
constexpr int BM = 256, BK = 64, HALF = 128, HTB = HALF * BK * 2  , STAGE_BYTES = 8 * HTB, NXCD = 8, WGM = 8;

__host__ __device__ __forceinline__ int lds_byte(int r, int c) { const int st = (r >> 4) * 2 + (c >> 5), rr = r & 15, cc = c & 31, ob = rr * 64 + cc * 2; return st * 1024 + (ob ^ (((ob >> 9) & 1) << 5)); }
__host__ __device__ __forceinline__ void stage_rc(int b, int& R, int& C) { const int st = b / 1024, sb = b % 1024, swz = sb ^ (((sb >> 9) & 1) << 5); R = (st >> 1) * 16 + swz / 64; C = (st & 1) * 32 + (swz % 64) / 2; }
__host__ __device__ __forceinline__ int perm32(int rho) { const int n = rho >> 4, i = rho & 15; return 8 * (i >> 2) + 4 * n + (i & 3); }

struct Unit { int pm, pn; };
struct Gemm { const bf16_t* A; const bf16_t* Bt; int M, N, K; };

struct StaticOrder {
    int nM, nN, nwg, G, c;
    __host__ __device__ void init(int M, int N, int G_, int c_) { nM = M / BM; nN = N / BM; nwg = nM * nN; G = G_; c = c_; }
    __host__ __device__ bool next(int i, Unit& u) const {
        const long L = (long)i * G + c; if (L >= nwg) return false;
        int wgid = (int)L; { const int q = nwg / NXCD, r = nwg % NXCD, xcd = wgid % NXCD, off = wgid / NXCD; wgid = (xcd < r ? xcd * (q + 1) : r * (q + 1) + (xcd - r) * q) + off; }
        const int nig = WGM * nN, gid = wgid / nig, fm = gid * WGM, gsz = (nM - fm) < WGM ? (nM - fm) : WGM;
        u.pm = fm + ((wgid % nig) % gsz); u.pn = (wgid % nig) / gsz; return true;
    }
    __device__ __forceinline__ void a_ready(const Unit&) const {}
    __device__ __forceinline__ void done(const Unit&) const {}
};

typedef float f32x2c_t __attribute__((ext_vector_type(2))); typedef __bf16 bf16x2c_t __attribute__((ext_vector_type(2)));
__device__ __forceinline__ unsigned cvt_pk_bf16(float lo, float hi) { f32x2c_t v = {lo, hi}; bf16x2c_t b = __builtin_convertvector(v, bf16x2c_t); return __builtin_bit_cast(unsigned, b); }
typedef float f32x2v __attribute__((ext_vector_type(2)));
__device__ __forceinline__ void st8(bf16_t* p, const float (&v)[8]) {
    u32x4 w; w.x = cvt_pk_bf16(v[0], v[1]); w.y = cvt_pk_bf16(v[2], v[3]); w.z = cvt_pk_bf16(v[4], v[5]); w.w = cvt_pk_bf16(v[6], v[7]); *(u32x4*)p = w;
}
__device__ __forceinline__ void ld8(const bf16_t* p, float (&v)[8]) {
    const u32x4 w = *(const u32x4*)p;
    v[0] = __uint_as_float(w.x << 16); v[1] = __uint_as_float(w.x & 0xffff0000u); v[2] = __uint_as_float(w.y << 16); v[3] = __uint_as_float(w.y & 0xffff0000u);
    v[4] = __uint_as_float(w.z << 16); v[5] = __uint_as_float(w.z & 0xffff0000u); v[6] = __uint_as_float(w.w << 16); v[7] = __uint_as_float(w.w & 0xffff0000u);
}
#define ACC8(dst, ai, bj, m) do { const f32x4 a0_ = acc[ai][bj][m][0], a1_ = acc[ai][bj][m][1]; dst[0] = a0_[0]; dst[1] = a0_[1]; dst[2] = a0_[2]; dst[3] = a0_[3]; dst[4] = a1_[0]; dst[5] = a1_[1]; dst[6] = a1_[2]; dst[7] = a1_[3]; } while (0)

struct Epi1 {
    static constexpr bool PERM = true, AFTER_DRAIN = false;
    bf16_t *QA, *QB, *GA; const float* gains; const float* T1; const float* T2;
    static constexpr size_t KA_OFF = (size_t)48 * 1048576 / 2, VA_OFF = (size_t)60 * 1048576 / 2, QKV_STRIDE = (size_t)72 * 1048576 / 2;
    __device__ __forceinline__ void operator()(const f32x4 (&acc)[2][2][4][2], const Unit& u, int wr, int wc, int fr, int fq) const {
        const int pn = u.pn, r0 = u.pm * BM;
        int seqbase, lgS; if (r0 < MPROMPT) { lgS = 12; seqbase = r0 & ~4095; } else { lgS = 11; seqbase = MPROMPT + ((r0 - MPROMPT) & ~2047); }
        if (pn >= 12) {
            bf16_t* G = GA + (pn < 16 ? (size_t)0 : (size_t)MTOK * 1024); const int cb = ((pn - 12) & 3) * 256 + wc * 32 + fq * 8;
#pragma unroll
            for (int ai = 0; ai < 2; ++ai)
#pragma unroll
                for (int m = 0; m < 4; ++m) { const size_t row = (size_t)(r0 + ai * HALF + wr * 64 + m * 16 + fr);
#pragma unroll
                    for (int bj = 0; bj < 2; ++bj) { float v[8]; ACC8(v, ai, bj, m);
#pragma unroll
                        for (int e = 0; e < 8; ++e) v[e] = __builtin_amdgcn_rcpf(1.0f + __builtin_amdgcn_exp2f(-1.4426950408889634f * v[e]));
                        st8(G + row * 1024 + cb + bj * HALF, v); } }
        } else if (pn >= 3) {
            const int kind = (pn - 3) / 3, g = (pn - 3) - 3 * kind, sh = 2 * g, lgL = lgS - sh;
            bf16_t* dst = QB + (size_t)kind * QKV_STRIDE + (size_t)g * MTOK * 256 + wc * 64 + fq * 8;
#pragma unroll
            for (int ai = 0; ai < 2; ++ai)
#pragma unroll
                for (int m = 0; m < 4; ++m) { const int row = r0 + ai * HALF + wr * 64 + m * 16 + fr, t = row - seqbase;
                    const size_t rowp = (size_t)(seqbase + ((t & ((1 << sh) - 1)) << lgL) + (t >> sh));
                    float v0[8], v1[8]; ACC8(v0, ai, 0, m); ACC8(v1, ai, 1, m);
                    if (kind < 2) {
                        const f32x4* tp = (const f32x4*)(T2 + (size_t)t * 16);
#pragma unroll
                        for (int k = 0; k < 4; ++k) { const f32x4 cs = tp[k];
                            { const float p = __shfl_xor(v0[2 * k], 16); const float o = v0[2 * k] * cs[0] + (fq == 0 ? -p : p) * cs[1]; v0[2 * k] = fq < 2 ? o : v0[2 * k]; }
                            { const float p = __shfl_xor(v0[2 * k + 1], 16); const float o = v0[2 * k + 1] * cs[2] + (fq == 0 ? -p : p) * cs[3]; v0[2 * k + 1] = fq < 2 ? o : v0[2 * k + 1]; } }
                        if (kind == 0) {
#pragma unroll
                            for (int e = 0; e < 8; ++e) { v0[e] *= QSCALE; v1[e] *= QSCALE; } }
                    }
                    st8(dst + rowp * 256, v0); st8(dst + rowp * 256 + 32, v1); }
        } else if (pn == 2 && wc >= 2) {
#pragma unroll
            for (int ai = 0; ai < 2; ++ai)
#pragma unroll
                for (int m = 0; m < 4; ++m) { const size_t row = (size_t)(r0 + ai * HALF + wr * 64 + m * 16 + fr);
#pragma unroll
                    for (int bj = 0; bj < 2; ++bj) { float v[8]; ACC8(v, ai, bj, m); st8(QA + VA_OFF + row * 128 + (wc - 2) * 64 + bj * 32 + fq * 8, v); } }
        } else {
            const bool isq = pn < 2; const float* gn = gains + (isq ? 0 : 64);
            float gv[2][8];
#pragma unroll
            for (int bj = 0; bj < 2; ++bj)
#pragma unroll
                for (int e = 0; e < 8; ++e) gv[bj][e] = gn[32 * bj + 8 * fq + e];
            bf16_t* dst = QA + (isq ? (size_t)((pn * 4 + wc) * 64) : KA_OFF + (size_t)(wc * 64)) + fq * 8; const int pitch = isq ? 512 : 128;
            const float osc = isq ? QSCALE : 1.0f;
#pragma unroll
            for (int ai = 0; ai < 2; ++ai)
#pragma unroll
                for (int m = 0; m < 4; ++m) { const int row = r0 + ai * HALF + wr * 64 + m * 16 + fr, t = row - seqbase;
                    float v[2][8]; ACC8(v[0], ai, 0, m); ACC8(v[1], ai, 1, m);
                    float ss = 0.f;
#pragma unroll
                    for (int bj = 0; bj < 2; ++bj)
#pragma unroll
                        for (int e = 0; e < 8; ++e) ss += v[bj][e] * v[bj][e];
                    ss += __shfl_xor(ss, 16); ss += __shfl_xor(ss, 32);
                    const float rinv = 1.0f / sqrtf(ss * (1.0f / 64.0f) + RMS_EPS);
#pragma unroll
                    for (int bj = 0; bj < 2; ++bj) { const int pos = bj == 0 ? (t >> 6) : (t & 63);
                        const f32x4* tp = (const f32x4*)(T1 + (size_t)pos * 32 + 16 * (fq & 1));
                        float o[8];
#pragma unroll
                        for (int k = 0; k < 4; ++k) { const f32x4 cs = tp[k];
                            { const float y = v[bj][2 * k] * rinv * gv[bj][2 * k]; const float p = __shfl_xor(y, 32); o[2 * k] = (y * cs[0] + (fq < 2 ? -p : p) * cs[1]) * osc; }
                            { const float y = v[bj][2 * k + 1] * rinv * gv[bj][2 * k + 1]; const float p = __shfl_xor(y, 32); o[2 * k + 1] = (y * cs[2] + (fq < 2 ? -p : p) * cs[3]) * osc; } }
                        st8(dst + (size_t)row * pitch + bj * 32, o); } }
        }
    }
};
struct Epi3a {
    static constexpr bool PERM = true, AFTER_DRAIN = false; const bf16_t* GA; bf16_t* MIX;
    __device__ __forceinline__ void operator()(const f32x4 (&acc)[2][2][4][2], const Unit& u, int wr, int wc, int fr, int fq) const {
        const int col0 = u.pn * BM + wc * 32 + fq * 8;
#pragma unroll
        for (int ai = 0; ai < 2; ++ai)
#pragma unroll
            for (int m = 0; m < 4; ++m) { const size_t row = (size_t)(u.pm * BM + ai * HALF + wr * 64 + m * 16 + fr);
#pragma unroll
                for (int bj = 0; bj < 2; ++bj) { float v[8], gq[8]; ACC8(v, ai, bj, m); ld8(GA + row * 1024 + col0 + bj * HALF, gq);
#pragma unroll
                    for (int e = 0; e < 8; ++e) v[e] *= gq[e];
                    st8(MIX + row * 1024 + col0 + bj * HALF, v); } }
    }
};
struct Epi3b {
    static constexpr bool PERM = true, AFTER_DRAIN = false; const bf16_t* GB; bf16_t* MIX;
    __device__ __forceinline__ void operator()(const f32x4 (&acc)[2][2][4][2], const Unit& u, int wr, int wc, int fr, int fq) const {
        const int col0 = u.pn * BM + wc * 32 + fq * 8;
#pragma unroll
        for (int ai = 0; ai < 2; ++ai)
#pragma unroll
            for (int m = 0; m < 4; ++m) { const size_t row = (size_t)(u.pm * BM + ai * HALF + wr * 64 + m * 16 + fr);
#pragma unroll
                for (int bj = 0; bj < 2; ++bj) { float v[8], gq[8], mx[8]; ACC8(v, ai, bj, m); ld8(GB + row * 1024 + col0 + bj * HALF, gq); ld8(MIX + row * 1024 + col0 + bj * HALF, mx);
#pragma unroll
                    for (int e = 0; e < 8; ++e) v[e] = mx[e] + v[e] * gq[e];
                    st8(MIX + row * 1024 + col0 + bj * HALF, v); } }
    }
};
struct Epi4 {
    static constexpr bool PERM = true, AFTER_DRAIN = false; const float* XP; long long xs_delta; float* X1; bf16_t* H2; const float* gm; float* SS;
    __device__ __forceinline__ void operator()(const f32x4 (&acc)[2][2][4][2], const Unit& u, int wr, int wc, int fr, int fq) const {
        const int col0 = u.pn * BM + wc * 32 + fq * 8, r0 = u.pm * BM;
        const float* X = (const float*)((const char*)XP + (r0 < MPROMPT ? 0ll : xs_delta)) + (size_t)r0 * 1024;
        float gv[2][8];
#pragma unroll
        for (int bj = 0; bj < 2; ++bj)
#pragma unroll
            for (int e = 0; e < 8; ++e) gv[bj][e] = gm[col0 + bj * HALF + e];
#pragma unroll
        for (int ai = 0; ai < 2; ++ai)
#pragma unroll
            for (int m = 0; m < 4; ++m) { const int rl = ai * HALF + wr * 64 + m * 16 + fr; const size_t row = (size_t)(r0 + rl); float ss = 0.f;
#pragma unroll
                for (int bj = 0; bj < 2; ++bj) { const float* xp = X + (size_t)rl * 1024 + col0 + bj * HALF; const f32x4 x0 = *(const f32x4*)xp, x1v = *(const f32x4*)(xp + 4);
                    const f32x4 y0 = x0 + acc[ai][bj][m][0], y1 = x1v + acc[ai][bj][m][1];
                    float* op = X1 + row * 1024 + col0 + bj * HALF; *(f32x4*)op = y0; *(f32x4*)(op + 4) = y1;
                    ss += (y0[0] * y0[0] + y0[1] * y0[1]) + (y0[2] * y0[2] + y0[3] * y0[3]) + (y1[0] * y1[0] + y1[1] * y1[1]) + (y1[2] * y1[2] + y1[3] * y1[3]);
                    float h[8] = {y0[0] * gv[bj][0], y0[1] * gv[bj][1], y0[2] * gv[bj][2], y0[3] * gv[bj][3], y1[0] * gv[bj][4], y1[1] * gv[bj][5], y1[2] * gv[bj][6], y1[3] * gv[bj][7]};
                    st8(H2 + row * 1024 + col0 + bj * HALF, h); }
                ss += __shfl_xor(ss, 16); ss += __shfl_xor(ss, 32);
                if (fq == 0) SS[row * 16 + u.pn * 4 + wc] = ss; }
    }
};
struct Epi5 {
    static constexpr bool PERM = true, AFTER_DRAIN = false; bf16_t* U; const float* SS;
    __device__ __forceinline__ void operator()(const f32x4 (&acc)[2][2][4][2], const Unit& u, int wr, int wc, int fr, int fq) const {
        const int col0 = u.pn * BM + wc * 32 + fq * 8;
#pragma unroll
        for (int ai = 0; ai < 2; ++ai)
#pragma unroll
            for (int m = 0; m < 4; ++m) { const size_t row = (size_t)(u.pm * BM + ai * HALF + wr * 64 + m * 16 + fr);
                const f32x4* sp = (const f32x4*)(SS + row * 16); const f32x4 s0 = sp[0], s1 = sp[1], s2 = sp[2], s3 = sp[3];
                const f32x4 sv = (s0 + s1) + (s2 + s3); const float tot = (sv[0] + sv[1]) + (sv[2] + sv[3]);
                const float r2 = 1.0f / (tot * (1.0f / 1024.0f) + RMS_EPS);
#pragma unroll
                for (int bj = 0; bj < 2; ++bj) { float v[8]; ACC8(v, ai, bj, m);
#pragma unroll
                    for (int e = 0; e < 8; ++e) { const float a = fmaxf(v[e], 0.f); v[e] = a * a * r2; }
                    st8(U + row * 4096 + col0 + bj * HALF, v); } }
    }
};
struct Epi6 {
    static constexpr bool PERM = true, AFTER_DRAIN = false; float* Y; float* SS;
    __device__ __forceinline__ void operator()(const f32x4 (&acc)[2][2][4][2], const Unit& u, int wr, int wc, int fr, int fq) const {
        const int col0 = u.pn * BM + wc * 32 + fq * 8;
#pragma unroll
        for (int ai = 0; ai < 2; ++ai)
#pragma unroll
            for (int m = 0; m < 4; ++m) { const size_t row = (size_t)(u.pm * BM + ai * HALF + wr * 64 + m * 16 + fr); float ss = 0.f;
#pragma unroll
                for (int bj = 0; bj < 2; ++bj) { float* op = Y + row * 1024 + col0 + bj * HALF; const f32x4 x0 = *(const f32x4*)op, x1v = *(const f32x4*)(op + 4);
                    const f32x4 y0 = x0 + acc[ai][bj][m][0], y1 = x1v + acc[ai][bj][m][1];
                    *(f32x4*)op = y0; *(f32x4*)(op + 4) = y1;
                    ss += (y0[0] * y0[0] + y0[1] * y0[1]) + (y0[2] * y0[2] + y0[3] * y0[3]) + (y1[0] * y1[0] + y1[1] * y1[1]) + (y1[2] * y1[2] + y1[3] * y1[3]); }
                ss += __shfl_xor(ss, 16); ss += __shfl_xor(ss, 32);
                if (fq == 0) SS[row * 16 + u.pn * 4 + wc] = ss; }
    }
};
#undef ACC8
template <class Epi, class Sched, bool ALIGN_EPI = false, bool SP2 = false>
__device__ __forceinline__ void gemm_phase(PG8_LAS unsigned char* lds, const Gemm g, const Sched& S, const Epi& E) {
    int tid_l = threadIdx.x; asm volatile("" : "+v"(tid_l));
    const int tid = tid_l, wid = __builtin_amdgcn_readfirstlane(tid >> 6), lane = tid & 63, wr = wid >> 2, wc = wid & 3, fr = lane & 15, fq = lane >> 4;
    const int K = g.K, nt = K / BK;
    unsigned voffA[2], voffB[2];
#pragma unroll
    for (int i = 0; i < 2; ++i) { int R, C; stage_rc(tid * 16 + i * 8192, R, C); const int Rb = Epi::PERM ? ((R & ~31) + perm32(R & 31)) : R;
        voffA[i] = (unsigned)(R * K + C) * 2u; voffB[i] = (unsigned)(Rb * K + C) * 2u; }
    const size_t kstep = (size_t)(BK * 2);
    const size_t hstep = (size_t)HALF * K * 2;
    const size_t tstep = 2 * hstep;
    const unsigned ldsw = (unsigned)wid * 1024u;
    const int aoff = lds_byte(wr * 64 + fr, fq * 8), boff = lds_byte(wc * 32 + fr, fq * 8);
#define PG8_SA(b, h) (((b) * 2 + (h)) * HTB)
#define PG8_SB(b, h) ((4 + (b) * 2 + (h)) * HTB)
#define PG8_STAGE(bufoff, gbase, voff) do { _Pragma("unroll") for (int _i = 0; _i < 2; ++_i) \
        __builtin_amdgcn_global_load_lds((const unsigned*)((const char*)(gbase) + (voff)[_i]), (PG8_LAS unsigned*)(lds + (bufoff) + ldsw + _i * 8192), 16, 0, 0); } while (0)
#define PG8_LDA(dst, b, h) do { _Pragma("unroll") for (int m = 0; m < 4; ++m) _Pragma("unroll") for (int k = 0; k < 2; ++k) dst[m][k] = *(const PG8_LAS bf16x8*)(lds + PG8_SA(b, h) + aoff + m * 2048 + k * 1024); } while (0)
#define PG8_LDB(dst, b, h) do { _Pragma("unroll") for (int n = 0; n < 2; ++n) _Pragma("unroll") for (int k = 0; k < 2; ++k) dst[n][k] = *(const PG8_LAS bf16x8*)(lds + PG8_SB(b, h) + boff + n * 2048 + k * 1024); } while (0)
#define PG8_MMA(ai, bj, At, Bt) do { __builtin_amdgcn_s_setprio(1); _Pragma("unroll") for (int m = 0; m < 4; ++m) _Pragma("unroll") for (int n = 0; n < 2; ++n) _Pragma("unroll") for (int k = 0; k < 2; ++k) \
        acc[ai][bj][m][n] = __builtin_amdgcn_mfma_f32_16x16x32_bf16(Bt[n][k], At[m][k], acc[ai][bj][m][n], 0, 0, 0); __builtin_amdgcn_s_setprio(0); } while (0)
#define PG8_WAIT_V(n) asm volatile("s_waitcnt vmcnt(" #n ")" ::: "memory")
#define PG8_WAIT_L(n) asm volatile("s_waitcnt lgkmcnt(" #n ")" ::: "memory")
#define PG8_BAR __builtin_amdgcn_s_barrier()
#define PG8_SCHED __builtin_amdgcn_sched_barrier(0)
    Unit cur, nxt; int ui = 0;
    if (!S.next(0, cur)) return;
    f32x4 acc[2][2][4][2];
#pragma unroll
    for (int a = 0; a < 2; ++a)
#pragma unroll
        for (int b = 0; b < 2; ++b)
#pragma unroll
            for (int m = 0; m < 4; ++m)
#pragma unroll
                for (int n = 0; n < 2; ++n) acc[a][b][m][n] = (f32x4){0.f, 0.f, 0.f, 0.f};
    bf16x8 At[4][2], B0[2][2], B1[2][2];
    const char* cA = (const char*)g.A + (size_t)cur.pm * tstep; const char* cB = (const char*)g.Bt + (size_t)cur.pn * tstep;
    S.a_ready(cur);
    if constexpr (SP2) {
        PG8_STAGE(PG8_SB(0, 0), cB, voffB); PG8_STAGE(PG8_SB(0, 1), cB + hstep, voffB); PG8_STAGE(PG8_SA(0, 0), cA, voffA); PG8_STAGE(PG8_SA(0, 1), cA + hstep, voffA);
        if (wr == 1) PG8_BAR;
        PG8_WAIT_V(2); PG8_BAR;
        PG8_STAGE(PG8_SB(1, 0), cB + kstep, voffB); PG8_STAGE(PG8_SA(1, 0), cA + kstep, voffA); PG8_STAGE(PG8_SB(1, 1), cB + hstep + kstep, voffB);
        PG8_WAIT_V(6); PG8_BAR;
    } else {
        PG8_STAGE(PG8_SB(0, 0), cB, voffB); PG8_STAGE(PG8_SA(0, 0), cA, voffA); PG8_STAGE(PG8_SB(0, 1), cB + hstep, voffB); PG8_STAGE(PG8_SA(0, 1), cA + hstep, voffA);
        if (wr == 1) PG8_BAR;
        PG8_WAIT_V(4); PG8_BAR;
        PG8_STAGE(PG8_SB(1, 0), cB + kstep, voffB); PG8_STAGE(PG8_SA(1, 0), cA + kstep, voffA); PG8_STAGE(PG8_SB(1, 1), cB + hstep + kstep, voffB);
        PG8_WAIT_V(6); PG8_BAR;
    }
    for (;;) {
        const bool has_next = S.next(ui + 1, nxt);
        const char* nA = has_next ? (const char*)g.A + (size_t)nxt.pm * tstep : cA; const char* nB = has_next ? (const char*)g.Bt + (size_t)nxt.pn * tstep : cB;
        for (int t = 0; t < nt; t += 2) {
            const bool last = (t == nt - 2);
            const char* a1 = cA + (size_t)(t + 1) * kstep;
            const char* a2 = last ? nA : cA + (size_t)(t + 2) * kstep; const char* b2 = last ? nB : cB + (size_t)(t + 2) * kstep;
            const char* a3 = a2 + kstep; const char* b3 = b2 + kstep;
            if (last && has_next) S.a_ready(nxt);
            if constexpr (SP2) {
            PG8_LDB(B0, 0, 0); PG8_LDB(B1, 0, 1); PG8_SCHED; PG8_LDA(At, 0, 0); PG8_STAGE(PG8_SA(1, 1), a1 + hstep, voffA);
            PG8_WAIT_V(8); PG8_WAIT_L(0); PG8_BAR; PG8_MMA(0, 0, At, B0); PG8_MMA(0, 1, At, B1); PG8_BAR; PG8_SCHED;
            PG8_LDA(At, 0, 1); PG8_STAGE(PG8_SB(0, 0), b2, voffB); PG8_STAGE(PG8_SB(0, 1), b2 + hstep, voffB); PG8_STAGE(PG8_SA(0, 0), a2, voffA);
            PG8_WAIT_V(8); PG8_WAIT_L(0); PG8_BAR; PG8_MMA(1, 0, At, B0); PG8_MMA(1, 1, At, B1); PG8_BAR; PG8_SCHED;
            PG8_LDB(B0, 1, 0); PG8_LDB(B1, 1, 1); PG8_SCHED; PG8_LDA(At, 1, 0); PG8_STAGE(PG8_SA(0, 1), a2 + hstep, voffA);
            PG8_WAIT_V(8); PG8_WAIT_L(0); PG8_BAR; PG8_MMA(0, 0, At, B0); PG8_MMA(0, 1, At, B1); PG8_BAR; PG8_SCHED;
            PG8_LDA(At, 1, 1); PG8_STAGE(PG8_SB(1, 0), b3, voffB); PG8_STAGE(PG8_SB(1, 1), b3 + hstep, voffB); PG8_STAGE(PG8_SA(1, 0), a3, voffA);
            PG8_WAIT_V(8); PG8_WAIT_L(0); PG8_BAR; PG8_MMA(1, 0, At, B0); PG8_MMA(1, 1, At, B1); PG8_BAR; PG8_SCHED;
            } else {
            PG8_LDB(B0, 0, 0); PG8_SCHED; PG8_LDA(At, 0, 0); PG8_STAGE(PG8_SA(1, 1), a1 + hstep, voffA);
            PG8_WAIT_L(8); PG8_BAR; PG8_WAIT_L(0); PG8_MMA(0, 0, At, B0); PG8_BAR; PG8_SCHED;
            PG8_LDB(B1, 0, 1); PG8_STAGE(PG8_SB(0, 0), b2, voffB);
            PG8_BAR; PG8_WAIT_L(0); PG8_MMA(0, 1, At, B1); PG8_BAR;
            PG8_LDA(At, 0, 1); PG8_STAGE(PG8_SA(0, 0), a2, voffA);
            PG8_BAR; PG8_WAIT_L(0); PG8_MMA(1, 0, At, B0); PG8_BAR; PG8_SCHED;
            PG8_STAGE(PG8_SB(0, 1), b2 + hstep, voffB);
            PG8_WAIT_V(6); PG8_BAR; PG8_MMA(1, 1, At, B1); PG8_BAR;
            PG8_LDB(B0, 1, 0); PG8_SCHED; PG8_LDA(At, 1, 0); PG8_STAGE(PG8_SA(0, 1), a2 + hstep, voffA);
            PG8_WAIT_L(8); PG8_BAR; PG8_WAIT_L(0); PG8_MMA(0, 0, At, B0); PG8_BAR; PG8_SCHED;
            PG8_LDB(B1, 1, 1); PG8_STAGE(PG8_SB(1, 0), b3, voffB);
            PG8_BAR; PG8_WAIT_L(0); PG8_MMA(0, 1, At, B1); PG8_BAR;
            PG8_LDA(At, 1, 1); PG8_STAGE(PG8_SA(1, 0), a3, voffA);
            PG8_BAR; PG8_WAIT_L(0); PG8_MMA(1, 0, At, B0); PG8_BAR; PG8_SCHED;
            PG8_STAGE(PG8_SB(1, 1), b3 + hstep, voffB);
            PG8_WAIT_V(6); PG8_BAR; PG8_MMA(1, 1, At, B1); PG8_BAR;
            }
        }
        if constexpr (ALIGN_EPI) { if (wr == 0) PG8_BAR; }
        if constexpr (!Epi::AFTER_DRAIN) { E(acc, cur, wr, wc, fr, fq); S.done(cur); }
        if (!has_next) break;
#pragma unroll
        for (int a = 0; a < 2; ++a)
#pragma unroll
            for (int b = 0; b < 2; ++b)
#pragma unroll
                for (int m = 0; m < 4; ++m)
#pragma unroll
                    for (int n = 0; n < 2; ++n) acc[a][b][m][n] = (f32x4){0.f, 0.f, 0.f, 0.f};
        cur = nxt; cA = nA; cB = nB; ++ui;
        if constexpr (ALIGN_EPI) { if (wr == 1) PG8_BAR; }
    }
    PG8_WAIT_V(0);
    if constexpr (!ALIGN_EPI) { if (wr == 0) PG8_BAR; }
    PG8_BAR;
    if constexpr (Epi::AFTER_DRAIN) { E.fused(acc, cur, wr, wc, fr, fq, lds, wid, lane); S.done(cur); }
#undef PG8_SA
#undef PG8_SB
#undef PG8_STAGE
#undef PG8_LDA
#undef PG8_LDB
#undef PG8_MMA
#undef PG8_WAIT_V
#undef PG8_WAIT_L
#undef PG8_BAR
#undef PG8_SCHED
}
}
#include <hip/hip_bf16.h>
namespace attn_body {
using bf16=__hip_bfloat16;
using bf16x8=__attribute__((ext_vector_type(8)))short;
using s16x4=__attribute__((ext_vector_type(4)))short;
using f32x16=__attribute__((ext_vector_type(16)))float;
using u32x4=__attribute__((ext_vector_type(4)))unsigned;
constexpr int D=64,QP=512,KP=128,VP=128,OP=512;
constexpr int NW=8,QBLK=32,QB=QBLK*NW,KVBLK=64;
constexpr int ATTN_UNIT_ROWS=QB;
__device__ __forceinline__ int crow(int r,int hi){return (r&3)+8*(r>>2)+4*hi;}
#define SBAR() __builtin_amdgcn_sched_barrier(0)
__device__ __forceinline__ void cmask(f32x16&p0,f32x16&p1,int jb,int qrel,int hi){
  const float NEG=-INFINITY; int kb=64*jb+4*hi;
  #pragma unroll
  for(int r=0;r<16;++r){int kv=kb+(r&3)+8*(r>>2); if(kv>qrel)p0[r]=NEG; if(kv+32>qrel)p1[r]=NEG;}
}

constexpr int NSLOT=3, SLOTB=8192;
constexpr int LDS_K=0, LDS_V=NSLOT*SLOTB, LDS_WS=2*NSLOT*SLOTB, LDS_OST=LDS_WS+NW*64*4, LDS_BYTES=LDS_OST+NW*4096;
constexpr float C2=0.125f*1.4426950408889634f;
__device__ __forceinline__ void glds16(const void*gsrc,unsigned lds_dst){unsigned keep;
  asm volatile("s_mov_b32 %0, m0\n\ts_mov_b32 m0, %2\n\ts_nop 0\n\tglobal_load_lds_dwordx4 %1, off\n\ts_mov_b32 m0, %0":"=&s"(keep):"v"(gsrc),"s"(lds_dst):"memory");}
__device__ __forceinline__ float max3f(float a,float b,float c){float r;asm("v_max3_f32 %0, %1, %2, %3":"=v"(r):"v"(a),"v"(b),"v"(c));return r;}
__device__ __forceinline__ float max2f(float a,float b){float r;asm("v_max_f32_e32 %0, %1, %2":"=v"(r):"v"(a),"v"(b));return r;}
__device__ __forceinline__ float fadd_s(float a,float b){float r;asm("v_add_f32_e32 %0, %1, %2":"=v"(r):"v"(a),"v"(b));return r;}
__device__ __forceinline__ float fsub_s(float a,float b){float r;asm("v_sub_f32_e32 %0, %1, %2":"=v"(r):"v"(a),"v"(b));return r;}
typedef float f32x2_t __attribute__((ext_vector_type(2))); typedef __bf16 bf16x2_t __attribute__((ext_vector_type(2)));
__device__ __forceinline__ unsigned cvtpk_s(float lo,float hi){f32x2_t v={lo,hi};bf16x2_t b=__builtin_convertvector(v,bf16x2_t);return __builtin_bit_cast(unsigned,b);}
#define WAIT_BAR(N) asm volatile("s_waitcnt vmcnt(" #N ") lgkmcnt(0)\n\ts_barrier":::"memory")

__device__ __forceinline__ void qkt(f32x16&p0,f32x16&p1,const char*Kslot,const bf16x8*qr,const f32x16&negm,int r32,int hi){
  const char*kb=Kslot+hi*1024+r32*16;
  #pragma unroll
  for(int d0=0;d0<4;++d0){
    const bf16x8 b0=*reinterpret_cast<const bf16x8*>(kb+d0*2048);
    const bf16x8 b1=*reinterpret_cast<const bf16x8*>(kb+d0*2048+512);
    if(d0==0){p0=__builtin_amdgcn_mfma_f32_32x32x16_bf16(b0,qr[0],negm,0,0,0);p1=__builtin_amdgcn_mfma_f32_32x32x16_bf16(b1,qr[0],negm,0,0,0);}
    else{p0=__builtin_amdgcn_mfma_f32_32x32x16_bf16(b0,qr[d0],p0,0,0,0);p1=__builtin_amdgcn_mfma_f32_32x32x16_bf16(b1,qr[d0],p1,0,0,0);}}
}
typedef __attribute__((address_space(3))) const char* lds_cptr;
typedef short v4i16_t __attribute__((ext_vector_type(4)));
__device__ __forceinline__ void kload8(bf16x8*kf,lds_cptr kp){
  kf[0]=*(const __attribute__((address_space(3))) bf16x8*)(kp);      kf[1]=*(const __attribute__((address_space(3))) bf16x8*)(kp+512);
  kf[2]=*(const __attribute__((address_space(3))) bf16x8*)(kp+2048); kf[3]=*(const __attribute__((address_space(3))) bf16x8*)(kp+2560);
  kf[4]=*(const __attribute__((address_space(3))) bf16x8*)(kp+4096); kf[5]=*(const __attribute__((address_space(3))) bf16x8*)(kp+4608);
  kf[6]=*(const __attribute__((address_space(3))) bf16x8*)(kp+6144); kf[7]=*(const __attribute__((address_space(3))) bf16x8*)(kp+6656);
}
__device__ __forceinline__ void kload2(bf16x8*kf,lds_cptr kp,int j){ kf[2*j]=*(const __attribute__((address_space(3))) bf16x8*)(kp+j*2048); kf[2*j+1]=*(const __attribute__((address_space(3))) bf16x8*)(kp+j*2048+512); }
__device__ __forceinline__ s16x4 vtr(lds_cptr p){ return __builtin_bit_cast(s16x4,__builtin_amdgcn_ds_read_tr16_b64_v4i16((__attribute__((address_space(3))) v4i16_t*)p)); }
__device__ __forceinline__ float rowmax(const f32x16&p0,const f32x16&p1){
  float a=max3f(p0[0],p0[1],p1[0]),b=max3f(p0[2],p0[3],p1[1]);a=max3f(a,p1[2],p1[3]);
  #pragma unroll
  for(int r=4;r<16;r+=4){a=max3f(a,p0[r],p0[r+1]);b=max3f(b,p0[r+2],p0[r+3]);a=max3f(a,p1[r],p1[r+1]);b=max3f(b,p1[r+2],p1[r+3]);}
  const float m=max2f(a,b);
  auto rr=__builtin_amdgcn_permlane32_swap(__float_as_uint(m),__float_as_uint(m),false,false);
  return max2f(__uint_as_float(rr[0]),__uint_as_float(rr[1]));
}
__device__ __forceinline__ void pv(f32x16*o,int vb,bf16x8 pa0,bf16x8 pa1,bf16x8 pa2,bf16x8 pa3){
  #pragma unroll
  for(int d0=0;d0<2;++d0){s16x4 lo[4],hi[4];
    #pragma unroll
    for(int ks=0;ks<4;++ks){
      asm volatile("ds_read_b64_tr_b16 %0,%1 offset:%c2":"=&v"(lo[ks]):"v"(vb),"i"(d0*4096+ks*1024):"memory");
      asm volatile("ds_read_b64_tr_b16 %0,%1 offset:%c2":"=&v"(hi[ks]):"v"(vb),"i"(d0*4096+ks*1024+512):"memory");}
    asm volatile("s_waitcnt lgkmcnt(0)":::"memory");SBAR();
    #define PK(k) (bf16x8){lo[k][0],lo[k][1],lo[k][2],lo[k][3],hi[k][0],hi[k][1],hi[k][2],hi[k][3]}
    o[d0]=__builtin_amdgcn_mfma_f32_32x32x16_bf16(pa0,PK(0),o[d0],0,0,0);
    o[d0]=__builtin_amdgcn_mfma_f32_32x32x16_bf16(pa1,PK(1),o[d0],0,0,0);
    o[d0]=__builtin_amdgcn_mfma_f32_32x32x16_bf16(pa2,PK(2),o[d0],0,0,0);
    o[d0]=__builtin_amdgcn_mfma_f32_32x32x16_bf16(pa3,PK(3),o[d0],0,0,0);
    #undef PK
  }
}

#ifndef ATTN_STORE16
#define ATTN_STORE16(p,v) (*(u32x4*)(p)=(v))
#endif
template<int THRL> __device__ __forceinline__ void attn_unit(const bf16*Qu,const bf16*__restrict__ Kh,const bf16*__restrict__ Vh,bf16*Ou,const int NT,char*shm){
  int tid_l=threadIdx.x; asm volatile("":"+v"(tid_l)); const int tid=tid_l,lane=tid&63,r32=lane&31,hi=lane>>5; const int wid=__builtin_amdgcn_readfirstlane(tid>>6);
  const bf16*Qw=Qu+(long)(wid*QBLK)*QP;
  const unsigned lds0=(unsigned)(uintptr_t)shm;
  float*wsf=(float*)(shm+LDS_WS)+wid*64;
  const bf16*ksrc=Kh+(long)lane*KP+wid*8;
  const bf16*vsrc=Vh+(long)(16*(wid&3)+(lane>>2))*VP+(wid>>2)*32+(lane&3)*8;
  const unsigned kdst=lds0+LDS_K+wid*1024, vdst=lds0+LDS_V+wid*1024;
  #define DMA_K(t,slot) glds16(ksrc+(long)(t)*KVBLK*KP,(unsigned)__builtin_amdgcn_readfirstlane(kdst+(slot)))
  #define DMA_V(t,slot) glds16(vsrc+(long)(t)*KVBLK*VP,(unsigned)__builtin_amdgcn_readfirstlane(vdst+(slot)))
  const int vb0=(int)(lds0+LDS_V)+((lane>>4)&1)*32+(lane&3)*8+(4*hi+((lane&15)>>2))*64;
  const char*Kbase=shm+LDS_K; bf16x8 kf[8];
  const lds_cptr shm3=(lds_cptr)shm; const lds_cptr kp0=shm3+LDS_K+hi*1024+r32*16; const lds_cptr vp0=shm3+LDS_V+((lane>>4)&1)*32+(lane&3)*8+(4*hi+((lane&15)>>2))*64;
  DMA_K(0,0);DMA_V(0,0);DMA_K(1,SLOTB);
  bf16x8 qr[4];
  #pragma unroll
  for(int d0=0;d0<4;++d0)qr[d0]=*reinterpret_cast<const bf16x8*>(&Qw[(long)r32*QP+d0*16+hi*8]);
  float mhat=0.f,l_reg=0.f;f32x16 o[2];o[0]=f32x16{};o[1]=f32x16{};f32x16 negm=f32x16{};asm volatile("":"+v"(negm));
  #define CMASK(P0,P1,t) do{}while(0)
  bool resc=false;
  #define START(P0,P1) do{ const float rm=rowmax(P0,P1); resc=false; \
    { const float dl=rm; mhat=fadd_s(mhat,dl); \
      _Pragma("unroll") for(int r=0;r<16;++r){P0[r]=fsub_s(P0[r],dl);P1[r]=fsub_s(P1[r],dl);} \
      _Pragma("unroll") for(int r=0;r<16;++r)negm[r]=-mhat; asm volatile("":"+v"(negm)); } \
    _Pragma("unroll") for(int r=0;r<16;++r)P0[r]=__builtin_amdgcn_exp2f(P0[r]); }while(0)
  #define RESC() do{ if(resc){ asm volatile("s_waitcnt lgkmcnt(0)":::"memory"); \
      _Pragma("unroll") for(int d_=0;d_<2;++d_) _Pragma("unroll") for(int r=0;r<16;++r)o[d_][r]*=wsf[crow(r,hi)]; } }while(0)
  f32x16 pA0,pA1,pB0,pB1;
  int sl_prev=0,sl_cur=0,sl_next=SLOTB;
  #define ROT() do{sl_prev=sl_cur;sl_cur=sl_next;sl_next=(sl_next==(NSLOT-1)*SLOTB)?0:sl_next+SLOTB;}while(0)
  DMA_K(2,2*SLOTB);
  WAIT_BAR(3);
  qkt(pA0,pA1,Kbase,qr,negm,r32,hi);asm volatile("s_nop 15\n\ts_nop 7":"+v"(pA0),"+v"(pA1));CMASK(pA0,pA1,0);
  START(pA0,pA1);
  _Pragma("unroll") for(int r=0;r<16;++r)pA1[r]=__builtin_amdgcn_exp2f(pA1[r]);
  WAIT_BAR(0);
  DMA_K(3,0);DMA_V(1,SLOTB);
  ROT();
  kload8(kf,kp0+sl_cur);
  WAIT_BAR(2);
  s16x4 vlo[8],vhi[8]; u32x4 pw0,pw1,pw2,pw3;
  #define PKW(P,B) cvtpk_s(P[B],P[B+1])
  #define PAF(k) __builtin_bit_cast(bf16x8,pw##k)
  #define VFR(i) (bf16x8){vlo[i][0],vlo[i][1],vlo[i][2],vlo[i][3],vhi[i][0],vhi[i][1],vhi[i][2],vhi[i][3]}
  #define PIN(x) asm volatile("":"+v"(x))
  #define MX3(a,b,c) __builtin_fmaxf(__builtin_fmaxf((a),(b)),(c))
  #define GAPA(MF,A0,A1,A2,A3,W0,W1,PW) do{ MF; sacc+=A0; sacc+=A1; sacc+=A2; sacc+=A3; PIN(sacc); W0; W1; PIN(PW); SBAR(); }while(0)
  #define EX(v) __builtin_amdgcn_exp2f(v)
  #define GAPB(MF,X,B) do{ MF; X[B]=EX(X[B]); X[B+1]=EX(X[B+1]); X[B+2]=EX(X[B+2]); X[B+3]=EX(X[B+3]); PIN(X); SBAR(); }while(0)
  #define VRD(i) do{ vlo[i]=vtr(vp_+(((i)>>2)*4096+((i)&3)*1024)); vhi[i]=vtr(vp_+(((i)>>2)*4096+((i)&3)*1024+512)); }while(0)
  #define KRD(G,j) do{ if(G){ kload2(kf,kp0+sl_next,j); SBAR(); } }while(0)
  #define STEP(C0,C1,P0,P1,t,GK,GV,GL) do{ SBAR(); \
    const lds_cptr vp_=vp0+sl_prev; \
    VRD(0); SBAR(); float sacc=(P0[0]+P0[1]); \
    GAPA(C0=__builtin_amdgcn_mfma_f32_32x32x16_bf16(kf[0],qr[0],negm,0,0,0), P0[2],P0[3],P0[4],P0[5],     pw0[0]=PKW(P0,0), pw0[1]=PKW(P0,2), pw0); \
    VRD(4); SBAR(); GAPA(C1=__builtin_amdgcn_mfma_f32_32x32x16_bf16(kf[1],qr[0],negm,0,0,0), P0[6],P0[7],P0[8],P0[9],     pw0[2]=PKW(P0,4), pw0[3]=PKW(P0,6), pw0); \
    VRD(1); SBAR(); GAPA(C0=__builtin_amdgcn_mfma_f32_32x32x16_bf16(kf[2],qr[1],C0,0,0,0),   P0[10],P0[11],P0[12],P0[13], pw1[0]=PKW(P0,8), pw1[1]=PKW(P0,10), pw1); \
    VRD(5); SBAR(); GAPA(C1=__builtin_amdgcn_mfma_f32_32x32x16_bf16(kf[3],qr[1],C1,0,0,0),   P0[14],P0[15],P1[0],P1[1],   pw1[2]=PKW(P0,12),pw1[3]=PKW(P0,14), pw1); \
    VRD(2); SBAR(); GAPA(C0=__builtin_amdgcn_mfma_f32_32x32x16_bf16(kf[4],qr[2],C0,0,0,0),   P1[2],P1[3],P1[4],P1[5],     pw2[0]=PKW(P1,0), pw2[1]=PKW(P1,2), pw2); \
    VRD(6); SBAR(); GAPA(C1=__builtin_amdgcn_mfma_f32_32x32x16_bf16(kf[5],qr[2],C1,0,0,0),   P1[6],P1[7],P1[8],P1[9],     pw2[2]=PKW(P1,4), pw2[3]=PKW(P1,6), pw2); \
    VRD(3); SBAR(); GAPA(C0=__builtin_amdgcn_mfma_f32_32x32x16_bf16(kf[6],qr[3],C0,0,0,0),   P1[10],P1[11],P1[12],P1[13], pw3[0]=PKW(P1,8), pw3[1]=PKW(P1,10), pw3); \
    VRD(7); SBAR(); GAPA(C1=__builtin_amdgcn_mfma_f32_32x32x16_bf16(kf[7],qr[3],C1,0,0,0),   P1[14],P1[15],0.f,0.f,       pw3[2]=PKW(P1,12),pw3[3]=PKW(P1,14), pw3); \
    l_reg+=sacc; \
    if(GK){DMA_K((t)+3,sl_cur);} if(GV){DMA_V((t)+1,sl_next);} \
    CMASK(C0,C1,t); \
    { float a=MX3(C0[0],C0[1],C1[0]),b=MX3(C0[2],C0[3],C1[1]); a=MX3(a,C1[2],C1[3]); \
      _Pragma("unroll") for(int r=4;r<16;r+=4){a=MX3(a,C0[r],C0[r+1]);b=MX3(b,C0[r+2],C0[r+3]);a=MX3(a,C1[r],C1[r+1]);b=MX3(b,C1[r+2],C1[r+3]);} \
      float rm=__builtin_fmaxf(a,b); { auto rr=__builtin_amdgcn_permlane32_swap(__float_as_uint(rm),__float_as_uint(rm),false,false); rm=__builtin_fmaxf(__uint_as_float(rr[0]),__uint_as_float(rr[1])); } \
      resc=false; \
      if(__builtin_expect(__any(rm>(float)THRL),0)){ const float dl=__builtin_fmaxf(rm,0.f); mhat+=dl; \
        _Pragma("unroll") for(int r=0;r<16;++r){C0[r]-=dl;C1[r]-=dl;} \
        _Pragma("unroll") for(int r=0;r<16;++r)negm[r]=-mhat; asm volatile("":"+v"(negm)); \
        const float f=__builtin_amdgcn_exp2f(-dl); l_reg*=f; if(hi==0)wsf[r32]=f; resc=true; } } \
    SBAR(); \
    GAPB(o[0]=__builtin_amdgcn_mfma_f32_32x32x16_bf16(PAF(0),VFR(0),o[0],0,0,0), C0,0); \
    GAPB(o[1]=__builtin_amdgcn_mfma_f32_32x32x16_bf16(PAF(0),VFR(4),o[1],0,0,0), C0,4); \
    KRD(GL,0); GAPB(o[0]=__builtin_amdgcn_mfma_f32_32x32x16_bf16(PAF(1),VFR(1),o[0],0,0,0), C0,8); \
    KRD(GL,1); GAPB(o[1]=__builtin_amdgcn_mfma_f32_32x32x16_bf16(PAF(1),VFR(5),o[1],0,0,0), C0,12); \
    KRD(GL,2); GAPB(o[0]=__builtin_amdgcn_mfma_f32_32x32x16_bf16(PAF(2),VFR(2),o[0],0,0,0), C1,0); \
    KRD(GL,3); GAPB(o[1]=__builtin_amdgcn_mfma_f32_32x32x16_bf16(PAF(2),VFR(6),o[1],0,0,0), C1,4); \
    GAPB(o[0]=__builtin_amdgcn_mfma_f32_32x32x16_bf16(PAF(3),VFR(3),o[0],0,0,0), C1,8); \
    GAPB(o[1]=__builtin_amdgcn_mfma_f32_32x32x16_bf16(PAF(3),VFR(7),o[1],0,0,0), C1,12); \
    }while(0)
  int t=1;
  #undef CMASK
  #define CMASK(P0,P1,t) do{}while(0)
  for(;t+5<NT;t+=2){
    STEP(pB0,pB1,pA0,pA1,t,true,true,true);     WAIT_BAR(2); RESC(); ROT();
    STEP(pA0,pA1,pB0,pB1,t+1,true,true,true);   WAIT_BAR(2); RESC(); ROT();
  }
  #undef CMASK
  #define CMASK(P0,P1,t) do{}while(0)
  #define ENDW(tt) do{ if((tt)+3<NT){WAIT_BAR(2);} else if((tt)+2<NT){WAIT_BAR(1);} else {WAIT_BAR(0);} }while(0)
  for(;t+1<NT;t+=2){
    STEP(pB0,pB1,pA0,pA1,t,(t+3<NT),(t+1<NT),(t+1<NT));       ENDW(t);   RESC(); ROT();
    STEP(pA0,pA1,pB0,pB1,t+1,(t+4<NT),(t+2<NT),(t+2<NT));     ENDW(t+1); RESC(); ROT();
  }
  STEP(pB0,pB1,pA0,pA1,NT-1,false,false,false); RESC();
  { float sacc=pB0[0]+pB0[1]; _Pragma("unroll") for(int r=2;r<16;++r)sacc+=pB0[r]; _Pragma("unroll") for(int r=0;r<16;++r)sacc+=pB1[r]; l_reg+=sacc;
    pw0=(u32x4){PKW(pB0,0),PKW(pB0,2),PKW(pB0,4),PKW(pB0,6)};pw1=(u32x4){PKW(pB0,8),PKW(pB0,10),PKW(pB0,12),PKW(pB0,14)};pw2=(u32x4){PKW(pB1,0),PKW(pB1,2),PKW(pB1,4),PKW(pB1,6)};pw3=(u32x4){PKW(pB1,8),PKW(pB1,10),PKW(pB1,12),PKW(pB1,14)};
    SBAR(); pv(o,vb0+sl_cur,PAF(0),PAF(1),PAF(2),PAF(3)); }
  #undef PKW
  #undef PAF
  #undef VFR
  #undef PIN
  #undef MX3
  #undef GAPA
  #undef GAPB
  #undef EX
  #undef VRD
  #undef KRD
  #undef STEP
  #undef ENDW
  {auto rr=__builtin_amdgcn_permlane32_swap(__float_as_uint(l_reg),__float_as_uint(l_reg),false,false);l_reg=__uint_as_float(rr[0])+__uint_as_float(rr[1]);}
  if(hi==0)wsf[32+r32]=l_reg;asm volatile("s_waitcnt lgkmcnt(0)":::"memory");
  float rli[16];
  #pragma unroll
  for(int r=0;r<16;++r)rli[r]=__builtin_amdgcn_rcpf(wsf[32+crow(r,hi)]);
  bf16*Ow=Ou+(long)(wid*QBLK)*OP;
  { bf16*stg=(bf16*)(shm+LDS_OST)+wid*2048;
    #pragma unroll
    for(int r=0;r<16;++r){const int orow=crow(r,hi);
      #pragma unroll
      for(int d0=0;d0<2;++d0)stg[orow*64+d0*32+r32]=__float2bfloat16(o[d0][r]*rli[r]);}
    asm volatile("s_waitcnt lgkmcnt(0)":::"memory");
    #pragma unroll
    for(int i=0;i<4;++i){const int row=i*8+(lane>>3),ch=lane&7; const u32x4 v=*(const u32x4*)(stg+row*64+ch*8); ATTN_STORE16(Ow+(long)row*OP+ch*8,v);} }
  asm volatile("s_waitcnt lgkmcnt(0)\n\ts_barrier":::"memory");
  #undef DMA_K
  #undef DMA_V
  #undef CMASK
  #undef START
  #undef RESC
  #undef ROT
}
constexpr int ATTN_LDS_BYTES=LDS_BYTES;
#undef SBAR
#undef WAIT_BAR
}
namespace dil {
using bf16x8 = __attribute__((ext_vector_type(8))) short;
using s16x4 = __attribute__((ext_vector_type(4))) short;
using f32x16 = __attribute__((ext_vector_type(16))) float;
using u32x4 = __attribute__((ext_vector_type(4))) unsigned;
typedef unsigned short bf16_t;
#define DLAS __attribute__((address_space(3)))
constexpr int VPITCH = 144, VBUF = 32 * VPITCH, WAVE_LDS = 2 * VBUF;
__device__ __forceinline__ int crow(int r, int hi) { return (r & 3) + 8 * (r >> 2) + 4 * hi; }
typedef float f32x2c_t __attribute__((ext_vector_type(2))); typedef __bf16 bf16x2c_t __attribute__((ext_vector_type(2)));
__device__ __forceinline__ unsigned cvtpk(float lo, float hi) { f32x2c_t v = {lo, hi}; bf16x2c_t b = __builtin_convertvector(v, bf16x2c_t); return __builtin_bit_cast(unsigned, b); }
__device__ __forceinline__ void dil_task(int task, const bf16_t* __restrict__ QB, const bf16_t* __restrict__ KB, const bf16_t* __restrict__ VB, bf16_t* OBP, float* LSE, DLAS char* vbuf, int lane) {
    const int r32 = lane & 31, hi = lane >> 5;
    const int h = task & 3, rbg = task >> 2, g = rbg / 1536, rb = rbg - g * 1536, sh = 2 * g, rowp0 = rb * 32;
    int seqbase, lgS; if (rowp0 < MPROMPT) { lgS = 12; seqbase = rowp0 & ~4095; } else { lgS = 11; seqbase = MPROMPT + ((rowp0 - MPROMPT) & ~2047); }
    const int lgL = lgS - sh, L = 1 << lgL, tl = rowp0 - seqbase, rho = tl >> lgL, u0 = tl & (L - 1), segbase = rowp0 - u0;
    const size_t goff = (size_t)g * MTOK * 256;
    const bf16_t* Qp = QB + goff + (size_t)(rowp0 + r32) * 256 + h * 64 + hi * 8;
    bf16x8 qf[4];
#pragma unroll
    for (int d0 = 0; d0 < 4; ++d0) qf[d0] = *(const bf16x8*)(Qp + d0 * 16);
    f32x16 p[5];
#pragma unroll
    for (int j = 0; j < 5; ++j) { int uu = u0 - 64 + 32 * j + r32; uu = uu < 0 ? 0 : (uu > L - 1 ? L - 1 : uu);
        const bf16_t* Kp = KB + goff + (size_t)(segbase + uu) * 256 + h * 64 + hi * 8;
        f32x16 a = f32x16{};
#pragma unroll
        for (int d0 = 0; d0 < 4; ++d0) a = __builtin_amdgcn_mfma_f32_32x32x16_bf16(*(const bf16x8*)(Kp + d0 * 16), qf[d0], a, 0, 0, 0);
        p[j] = a; }
#define DIL_VLOAD(dst, j) do { _Pragma("unroll") for (int i = 0; i < 4; ++i) { const int c = lane + 64 * i, kk = c >> 3, ch = c & 7; int uu = u0 - 64 + 32 * (j) + kk; uu = uu < 0 ? 0 : (uu > L - 1 ? L - 1 : uu); \
        dst[i] = *(const u32x4*)(VB + goff + (size_t)(segbase + uu) * 256 + h * 64 + ch * 8); } } while (0)
    u32x4 vreg[2][4];
    DIL_VLOAD(vreg[0], 0); DIL_VLOAD(vreg[1], 1);
    float mx = -INFINITY;
#pragma unroll
    for (int j = 0; j < 5; ++j)
#pragma unroll
        for (int r = 0; r < 16; ++r) { const int rel = 32 * j - 64 + crow(r, hi) - r32, uk = u0 + r32 + rel;
            const bool valid = (rel >= -64) && (rel <= 64) && (uk >= 0) && (uk < L);
            const float s = valid ? p[j][r] : -INFINITY; p[j][r] = s; mx = fmaxf(mx, s); }
    mx = fmaxf(mx, __shfl_xor(mx, 32));
    float l = 0.f;
#pragma unroll
    for (int j = 0; j < 5; ++j)
#pragma unroll
        for (int r = 0; r < 16; ++r) { const float e = __builtin_amdgcn_exp2f(p[j][r] - mx); p[j][r] = e; l += e; }
    l += __shfl_xor(l, 32);
    f32x16 o[2]; o[0] = f32x16{}; o[1] = f32x16{};
    const unsigned vb0 = (unsigned)(uintptr_t)vbuf + (unsigned)((4 * hi + ((lane & 15) >> 2)) * VPITCH + ((lane >> 4) & 1) * 32 + (lane & 3) * 8);
#pragma unroll
    for (int j = 0; j < 5; ++j) { DLAS char* buf = vbuf + (j & 1) * VBUF; const unsigned vb = vb0 + (unsigned)((j & 1) * VBUF);
#pragma unroll
        for (int i = 0; i < 4; ++i) { const int c = lane + 64 * i, kk = c >> 3, ch = c & 7; *(DLAS u32x4*)(buf + kk * VPITCH + ch * 16) = vreg[j & 1][i]; }
        if (j + 2 < 5) DIL_VLOAD(vreg[j & 1], j + 2);
        asm volatile("s_waitcnt lgkmcnt(0)" ::: "memory");
        s16x4 lo[2][2], hh[2][2];
#pragma unroll
        for (int ks = 0; ks < 2; ++ks)
#pragma unroll
            for (int db = 0; db < 2; ++db) {
                asm volatile("ds_read_b64_tr_b16 %0, %1 offset:%c2" : "=&v"(lo[ks][db]) : "v"(vb), "i"(ks * 16 * VPITCH + db * 64) : "memory");
                asm volatile("ds_read_b64_tr_b16 %0, %1 offset:%c2" : "=&v"(hh[ks][db]) : "v"(vb), "i"(ks * 16 * VPITCH + db * 64 + 8 * VPITCH) : "memory"); }
        asm volatile("s_waitcnt lgkmcnt(0)" ::: "memory"); __builtin_amdgcn_sched_barrier(0);
#pragma unroll
        for (int ks = 0; ks < 2; ++ks) { u32x4 pw; pw.x = cvtpk(p[j][8 * ks + 0], p[j][8 * ks + 1]); pw.y = cvtpk(p[j][8 * ks + 2], p[j][8 * ks + 3]); pw.z = cvtpk(p[j][8 * ks + 4], p[j][8 * ks + 5]); pw.w = cvtpk(p[j][8 * ks + 6], p[j][8 * ks + 7]);
            const bf16x8 pa = __builtin_bit_cast(bf16x8, pw);
#pragma unroll
            for (int db = 0; db < 2; ++db) { const bf16x8 vf = (bf16x8){lo[ks][db][0], lo[ks][db][1], lo[ks][db][2], lo[ks][db][3], hh[ks][db][0], hh[ks][db][1], hh[ks][db][2], hh[ks][db][3]};
                o[db] = __builtin_amdgcn_mfma_f32_32x32x16_bf16(pa, vf, o[db], 0, 0, 0); } }
    }
    const float linv = 1.0f / l, lse2 = mx + __builtin_amdgcn_logf(l);
#pragma unroll
    for (int r = 0; r < 16; ++r) { const int q = crow(r, hi); const float rl = __shfl(linv, q); const size_t row = (size_t)(seqbase + rho + ((u0 + q) << sh));
        bf16_t* op = OBP + goff + row * 256 + h * 64 + r32;
        op[0] = (bf16_t)(cvtpk(o[0][r] * rl, 0.f) & 0xffffu); op[32] = (bf16_t)(cvtpk(o[1][r] * rl, 0.f) & 0xffffu); }
    if (hi == 0) LSE[((size_t)g * MTOK + (size_t)(seqbase + rho + ((u0 + r32) << sh))) * 4 + h] = lse2;
}
#undef DIL_VLOAD
}

constexpr size_t MiB = 1u << 20;
constexpr size_t WS_GN = 1 * MiB - 4096, WS_T1 = 1 * MiB, WS_T2 = 1 * MiB + 65536, WS_SS1 = 2 * MiB, WS_SS2 = 5 * MiB, WS_LSE = 8 * MiB;
constexpr size_t WS_WUP = 12 * MiB, WS_WDN = 20 * MiB;
constexpr size_t WS_U = 28 * MiB, WS_H2 = 412 * MiB, WS_END = 508 * MiB;
constexpr size_t WS_W1 = 28 * MiB, WS_WA = 38 * MiB, WS_WB = 39 * MiB, WS_WO = 40 * MiB;
constexpr size_t WS_H1 = 44 * MiB, WS_OBP = 44 * MiB, WS_OB = 116 * MiB;
constexpr size_t WS_QA = 140 * MiB, WS_KA = 188 * MiB, WS_VA = 200 * MiB, WS_QB = 212 * MiB, WS_KB = 284 * MiB, WS_VB = 356 * MiB, WS_OA = 428 * MiB;
constexpr size_t WS_MIX = 212 * MiB;
constexpr int LDS_BYTES = 147456, NWAVES = 8;
#define LAS __attribute__((address_space(3)))
typedef unsigned short bf16;
typedef unsigned v4u __attribute__((ext_vector_type(4)));
typedef float f32x4 __attribute__((ext_vector_type(4)));
__device__ __forceinline__ unsigned f2bf(float f) { unsigned u = __builtin_bit_cast(unsigned, f); return (u + 0x7fffu + ((u >> 16) & 1u)) >> 16; }
__device__ __forceinline__ unsigned pk2(float lo, float hi) { return f2bf(lo) | (f2bf(hi) << 16); }
__device__ __forceinline__ float wave_sum(float v) {
#pragma unroll
    for (int o = 1; o < 64; o <<= 1) v += __shfl_xor(v, o);
    return v;
}
__device__ __forceinline__ void p0_transpose_item(const float* W, int K, int N, bf16* WT, int k0, int n0, int orow0, LAS float* scr, int lane) {
#pragma unroll 8
    for (int i = 0; i < 32; ++i) { const int kk = 2 * i + (lane >> 5); scr[kk * 33 + (lane & 31)] = W[(size_t)(k0 + kk) * N + n0 + (lane & 31)]; }
    asm volatile("s_waitcnt lgkmcnt(0)" ::: "memory");
    const int c = lane & 7;
#pragma unroll
    for (int j = 0; j < 4; ++j) { const int n = (lane >> 3) + 8 * j; const LAS float* s = scr + (8 * c) * 33 + n;
        v4u o; o.x = pk2(s[0 * 33], s[1 * 33]); o.y = pk2(s[2 * 33], s[3 * 33]); o.z = pk2(s[4 * 33], s[5 * 33]); o.w = pk2(s[6 * 33], s[7 * 33]);
        *(v4u*)(WT + (size_t)(orow0 + n) * K + k0 + 8 * c) = o; }
    asm volatile("s_waitcnt lgkmcnt(0)" ::: "memory");
}
__device__ __forceinline__ void transpose_matrix(const float* W, int K, int N, bf16* WT, bool perm, LAS float* scr, int lane, int gw, int NGW) {
    const int nblk = N / 32, nitems = (K / 64) * nblk;
    for (int it = gw; it < nitems; it += NGW) { const int kb = it / nblk, nb = it - kb * nblk, n0 = 32 * nb; int orow0 = n0;
        if (perm && n0 < 3072) { const int nl = n0 & 255; orow0 = (n0 & ~255) + 128 * ((nl >> 5) & 1) + 32 * (nl >> 6); }
        p0_transpose_item(W, K, N, WT, 64 * kb, n0, orow0, scr, lane); }
}

struct Args { const float* in[13]; float* out; unsigned char* ws; };
__global__ void __launch_bounds__(NWAVES * 64, 2) fwd_megakernel(Args args) {
    extern __shared__ __attribute__((aligned(16))) unsigned char lds[];
    cg::grid_group grid = cg::this_grid();
    LAS unsigned char* ldsl = (LAS unsigned char*)lds;
#define GEOM() int tid_l = threadIdx.x; asm volatile("" : "+v"(tid_l)); const int tid = tid_l, lane = tid & 63, wave = __builtin_amdgcn_readfirstlane(tid >> 6); (void)lane; const int G = gridDim.x, bx = blockIdx.x, vcu = (G % 8 == 0) ? (bx % 8) * (G / 8) + bx / 8 : bx, gw = vcu * NWAVES + wave, NGW = G * NWAVES; (void)vcu; (void)gw; (void)NGW
#define WSP(T, off) ((T*)(args.ws + (off)))
#define GRID_SYNC() do { ++sync_no; asm volatile("s_waitcnt vmcnt(0) lgkmcnt(0)" ::: "memory");     \
    __syncthreads(); \
    if (threadIdx.x == 0) { __builtin_amdgcn_fence(__ATOMIC_RELEASE, "agent"); asm volatile("s_waitcnt vmcnt(0)" ::: "memory");     \
        unsigned* ctr_ = (unsigned*)args.ws; __hip_atomic_fetch_add(ctr_, 1u, __ATOMIC_RELAXED, __HIP_MEMORY_SCOPE_AGENT); const unsigned want_ = sync_no * gridDim.x; \
        while (__hip_atomic_load(ctr_, __ATOMIC_RELAXED, __HIP_MEMORY_SCOPE_AGENT) < want_) __builtin_amdgcn_s_sleep(1); \
        __builtin_amdgcn_fence(__ATOMIC_ACQUIRE, "agent"); asm volatile("s_waitcnt vmcnt(0)" ::: "memory"); }     \
    __syncthreads(); } while (0)
    unsigned sync_no = 0u;
    grid.sync();

    {
        GEOM();
        LAS float* scr = (LAS float*)(ldsl + wave * 16384);
        transpose_matrix(args.in[2], 1024, 5120, WSP(bf16, WS_W1), true, scr, lane, gw, NGW);
        transpose_matrix(args.in[3], 512, 1024, WSP(bf16, WS_WA), false, scr, lane, gw, NGW);
        transpose_matrix(args.in[4], 256, 1024, WSP(bf16, WS_WB), false, scr, lane, gw, NGW);
        transpose_matrix(args.in[5], 1024, 1024, WSP(bf16, WS_WO), false, scr, lane, gw, NGW);
        transpose_matrix(args.in[10], 1024, 4096, WSP(bf16, WS_WUP), false, scr, lane, gw, NGW);
        transpose_matrix(args.in[11], 4096, 1024, WSP(bf16, WS_WDN), false, scr, lane, gw, NGW);
        float* T1 = WSP(float, WS_T1); float* T2 = WSP(float, WS_T2); float* GN = WSP(float, WS_GN);
        const int gt = bx * (NWAVES * 64) + tid, NT_ = G * NWAVES * 64;
        for (int i = gt; i < 64 * 16 + 4096 * 8 + 128; i += NT_) {
            if (i < 1024) { const int pos = i >> 4, k = i & 15; const float fr = (float)pow(10000.0, -(double)k / 16.0); const float ang = (float)pos * fr;
                T1[2 * i] = (float)cos((double)ang); T1[2 * i + 1] = (float)sin((double)ang); }
            else if (i < 1024 + 32768) { const int j = i - 1024, pos = j >> 3, k = j & 7; const float fr = (float)pow(500000.0, -(double)k / 8.0); const float ang = (float)pos * fr;
                T2[2 * j] = (float)cos((double)ang); T2[2 * j + 1] = (float)sin((double)ang); }
            else { const int j = i - 1024 - 32768; GN[j] = j < 64 ? args.in[7][j] : args.in[8][j - 64]; }
        }
        const float *xp = args.in[0], *xs = args.in[1], *g_mix = args.in[6]; bf16* H1 = WSP(bf16, WS_H1);
        for (int m = gw; m < MTOK; m += NGW) {
            const float* xrow = m < MPROMPT ? xp + (size_t)m * 1024 : xs + (size_t)(m - MPROMPT) * 1024;
            const f32x4* xr = (const f32x4*)xrow + lane; const f32x4* gr = (const f32x4*)g_mix + lane;
            f32x4 v[4]; float s = 0.f;
#pragma unroll
            for (int j = 0; j < 4; ++j) { v[j] = xr[64 * j]; s += (v[j].x * v[j].x + v[j].y * v[j].y) + (v[j].z * v[j].z + v[j].w * v[j].w); }
            const float rinv = 1.0f / sqrtf(wave_sum(s) * (1.0f / 1024.0f) + RMS_EPS);
            unsigned long long* o8 = (unsigned long long*)(H1 + (size_t)m * 1024) + lane;
#pragma unroll
            for (int j = 0; j < 4; ++j) { const f32x4 gq = gr[64 * j]; o8[64 * j] = (unsigned long long)pk2(v[j].x * rinv * gq.x, v[j].y * rinv * gq.y) | ((unsigned long long)pk2(v[j].z * rinv * gq.z, v[j].w * rinv * gq.w) << 32); }
        }
    }
    GRID_SYNC();
    {
        GEOM();
        pg8::Gemm g{WSP(bf16, WS_H1), WSP(bf16, WS_W1), MTOK, 5120, 1024}; pg8::StaticOrder S; S.init(MTOK, 5120, G, bx);
        pg8::Epi1 E{WSP(bf16, WS_QA), WSP(bf16, WS_QB), (bf16*)args.out, WSP(float, WS_GN), WSP(float, WS_T1), WSP(float, WS_T2)};
        pg8::gemm_phase<pg8::Epi1, pg8::StaticOrder, true, true>(ldsl, g, S, E);
    }
    GRID_SYNC();
    {
        GEOM();
        LAS char* vbuf = (LAS char*)ldsl + wave * dil::WAVE_LDS;
        for (int task = gw; task < 3 * 1536 * 4; task += NGW) dil::dil_task(task, WSP(bf16, WS_QB), WSP(bf16, WS_KB), WSP(bf16, WS_VB), WSP(bf16, WS_OBP), WSP(float, WS_LSE), vbuf, lane);
    }
    GRID_SYNC();
    {
        GEOM();
        {
        const float* LSE = WSP(float, WS_LSE); const bf16* OBP = WSP(bf16, WS_OBP); bf16* OB = WSP(bf16, WS_OB);
        const int gt = bx * (NWAVES * 64) + tid, NT_ = G * NWAVES * 64;
        for (int idx = gt; idx < MTOK * 32; idx += NT_) { const int row = idx >> 5, ch = idx & 31, h = ch >> 3;
            const float l0 = LSE[((size_t)row) * 4 + h], l1 = LSE[((size_t)MTOK + row) * 4 + h], l2 = LSE[((size_t)2 * MTOK + row) * 4 + h];
            const float mx = fmaxf(l0, fmaxf(l1, l2)); float w0 = __builtin_amdgcn_exp2f(l0 - mx), w1 = __builtin_amdgcn_exp2f(l1 - mx), w2 = __builtin_amdgcn_exp2f(l2 - mx);
            const float inv = 1.0f / (w0 + w1 + w2); w0 *= inv; w1 *= inv; w2 *= inv;
            float a[8], b[8], c[8], o[8]; pg8::ld8(OBP + (size_t)row * 256 + ch * 8, a); pg8::ld8(OBP + ((size_t)MTOK + row) * 256 + ch * 8, b); pg8::ld8(OBP + ((size_t)2 * MTOK + row) * 256 + ch * 8, c);
#pragma unroll
            for (int e = 0; e < 8; ++e) o[e] = w0 * a[e] + w1 * b[e] + w2 * c[e];
            pg8::st8(OB + (size_t)row * 256 + ch * 8, o); }
        }
        __syncthreads();
        const attn_body::bf16* QA = WSP(const attn_body::bf16, WS_QA); const attn_body::bf16* KA = WSP(const attn_body::bf16, WS_KA); const attn_body::bf16* VA = WSP(const attn_body::bf16, WS_VA); attn_body::bf16* OA = WSP(attn_body::bf16, WS_OA);
        for (int vv = vcu; vv < 256; vv += G) {
            for (int i = 0; i < 6; ++i) {
                int b, h, qb, nt; size_t rb;
                if (i < 2) { const int id = 2 * vv + i; b = id >> 7; h = (id >> 4) & 7; qb = id & 15; rb = (size_t)b * 4096; nt = 64; }
                else { const int id = 4 * vv + (i - 2); b = id >> 6; h = (id >> 3) & 7; qb = id & 7; rb = (size_t)MPROMPT + (size_t)b * 2048; nt = 32; }
                attn_body::attn_unit<8>(QA + (rb + qb * 256) * 512 + h * 64, KA + rb * 128 + (h >> 2) * 64, VA + rb * 128 + (h >> 2) * 64, OA + (rb + qb * 256) * 512 + h * 64, nt, (char*)lds);
            }
        }
    }
    GRID_SYNC();
    {
        GEOM();
        pg8::Gemm g{WSP(bf16, WS_OA), WSP(bf16, WS_WA), MTOK, 1024, 512}; pg8::StaticOrder S; S.init(MTOK, 1024, G, bx);
        pg8::Epi3a E{(const bf16*)args.out, WSP(bf16, WS_MIX)};
        pg8::gemm_phase<pg8::Epi3a, pg8::StaticOrder, true, true>(ldsl, g, S, E);
    }
    __syncthreads();
    {
        GEOM();
        pg8::Gemm g{WSP(bf16, WS_OB), WSP(bf16, WS_WB), MTOK, 1024, 256}; pg8::StaticOrder S; S.init(MTOK, 1024, G, bx);
        pg8::Epi3b E{(const bf16*)args.out + (size_t)MTOK * 1024, WSP(bf16, WS_MIX)};
        pg8::gemm_phase<pg8::Epi3b, pg8::StaticOrder, true, true>(ldsl, g, S, E);
    }
    GRID_SYNC();
    {
        GEOM();
        pg8::Gemm g{WSP(bf16, WS_MIX), WSP(bf16, WS_WO), MTOK, 1024, 1024}; pg8::StaticOrder S; S.init(MTOK, 1024, G, bx);
        pg8::Epi4 E{args.in[0], (long long)((const char*)args.in[1] - (const char*)args.in[0]) - (long long)MPROMPT * 4096, args.out, WSP(bf16, WS_H2), args.in[9], WSP(float, WS_SS1)};
        pg8::gemm_phase<pg8::Epi4, pg8::StaticOrder, true, true>(ldsl, g, S, E);
    }
    GRID_SYNC();
    {
        GEOM();
        pg8::Gemm g{WSP(bf16, WS_H2), WSP(bf16, WS_WUP), MTOK, 4096, 1024}; pg8::StaticOrder S; S.init(MTOK, 4096, G, bx);
        pg8::Epi5 E{WSP(bf16, WS_U), WSP(float, WS_SS1)};
        pg8::gemm_phase<pg8::Epi5, pg8::StaticOrder, true, true>(ldsl, g, S, E);
    }
    GRID_SYNC();
    {
        GEOM();
        pg8::Gemm g{WSP(bf16, WS_U), WSP(bf16, WS_WDN), MTOK, 1024, 4096}; pg8::StaticOrder S; S.init(MTOK, 1024, G, bx);
        pg8::Epi6 E{args.out, WSP(float, WS_SS2)};
        pg8::gemm_phase<pg8::Epi6, pg8::StaticOrder, true, true>(ldsl, g, S, E);
    }
    GRID_SYNC();
    {
        GEOM();
        float* out = args.out; const float* SS2 = WSP(float, WS_SS2); const float* g_fin = args.in[12];
        for (int m = gw; m < MTOK; m += NGW) {
            f32x4* xr = (f32x4*)(out + (size_t)m * 1024) + lane; const f32x4* gr = (const f32x4*)g_fin + lane;
            float s = lane < 16 ? SS2[(size_t)m * 16 + lane] : 0.f;
            const float rinv = 1.0f / sqrtf(wave_sum(s) * (1.0f / 1024.0f) + RMS_EPS);
#pragma unroll
            for (int j = 0; j < 4; ++j) { const f32x4 v = xr[64 * j], gq = gr[64 * j]; xr[64 * j] = v * rinv * gq; }
        }
    }
}

extern "C" void kernel_launch(void* const* d_in, const int* in_sizes, int n_in, void* d_out, int out_size, void* d_ws, size_t ws_size, hipStream_t stream) {
    static int grid = 0;
    if (grid == 0) {
        if (n_in != 13 || out_size != MTOK * 1024 || ws_size < WS_END) { fprintf(stderr, "kernel_launch: unexpected shapes (n_in %d, out %d, ws %zu)\n", n_in, out_size, ws_size); grid = -1; return; }
        int dev = 0, cus = 0, per_cu = 0;
        (void)hipGetDevice(&dev); (void)hipDeviceGetAttribute(&cus, hipDeviceAttributeMultiprocessorCount, dev);
        if (hipFuncSetAttribute((const void*)fwd_megakernel, hipFuncAttributeMaxDynamicSharedMemorySize, LDS_BYTES) != hipSuccess) { fprintf(stderr, "kernel_launch: hipFuncSetAttribute failed\n"); grid = -1; return; }
        if (hipOccupancyMaxActiveBlocksPerMultiprocessor(&per_cu, (const void*)fwd_megakernel, NWAVES * 64, LDS_BYTES) != hipSuccess || per_cu < 1) { fprintf(stderr, "kernel_launch: occupancy query says %d blocks per CU\n", per_cu); (void)hipGetLastError(); grid = -1; return; }
        grid = cus;
        if (grid > 256) grid = 256;
    }
    if (grid < 0) return;
    (void)hipMemsetAsync(d_ws, 0, 4096, stream);
    Args a{};
    for (int i = 0; i < 13; ++i) a.in[i] = (const float*)d_in[i];
    a.out = (float*)d_out; a.ws = (unsigned char*)d_ws;
    void* kargs[] = {&a};
    hipError_t e = hipLaunchCooperativeKernel((const void*)fwd_megakernel, dim3(grid), dim3(NWAVES * 64), kargs, LDS_BYTES, stream);
    if (e != hipSuccess) fprintf(stderr, "kernel_launch: cooperative launch failed: %s (grid %d)\n", hipGetErrorString(e), grid);
}
```

```cpp
#include <hip/hip_runtime.h>
#include <hip/hip_cooperative_groups.h>
#include <hip/hip_bf16.h>
#include <cstdio>
#include <cstdint>
#include <cmath>
namespace cg = cooperative_groups;
constexpr int MTOK = 49152, MPROMPT = 16384;
constexpr float RMS_EPS = 1e-6f;
constexpr float QSCALE = 0.125f * 1.4426950408889634f;
namespace pg8 {
#define PG8_LAS __attribute__((address_space(3)))
typedef unsigned short bf16_t;
typedef short bf16x8 __attribute__((ext_vector_type(8)));
typedef float f32x4 __attribute__((ext_vector_type(4)));
typedef unsigned u32x4 __attribute__((ext_vector_type(4)));
constexpr int BM = 256, BK = 64, HALF = 128, HTB = HALF * BK * 2  , STAGE_BYTES = 8 * HTB, NXCD = 8, WGM = 8;

__host__ __device__ __forceinline__ int lds_byte(int r, int c) { const int st = (r >> 4) * 2 + (c >> 5), rr = r & 15, cc = c & 31, ob = rr * 64 + cc * 2; return st * 1024 + (ob ^ (((ob >> 9) & 1) << 5)); }
__host__ __device__ __forceinline__ void stage_rc(int b, int& R, int& C) { const int st = b / 1024, sb = b % 1024, swz = sb ^ (((sb >> 9) & 1) << 5); R = (st >> 1) * 16 + swz / 64; C = (st & 1) * 32 + (swz % 64) / 2; }
__host__ __device__ __forceinline__ int perm32(int rho) { const int n = rho >> 4, i = rho & 15; return 8 * (i >> 2) + 4 * n + (i & 3); }

struct Unit { int pm, pn; };
struct Gemm { const bf16_t* A; const bf16_t* Bt; int M, N, K; };

struct StaticOrder {
    int nM, nN, nwg, G, c;
    __host__ __device__ void init(int M, int N, int G_, int c_) { nM = M / BM; nN = N / BM; nwg = nM * nN; G = G_; c = c_; }
    __host__ __device__ bool next(int i, Unit& u) const {
        const long L = (long)i * G + c; if (L >= nwg) return false;
        int wgid = (int)L; { const int q = nwg / NXCD, r = nwg % NXCD, xcd = wgid % NXCD, off = wgid / NXCD; wgid = (xcd < r ? xcd * (q + 1) : r * (q + 1) + (xcd - r) * q) + off; }
        const int nig = WGM * nN, gid = wgid / nig, fm = gid * WGM, gsz = (nM - fm) < WGM ? (nM - fm) : WGM;
        u.pm = fm + ((wgid % nig) % gsz); u.pn = (wgid % nig) / gsz; return true;
    }
    __device__ __forceinline__ void a_ready(const Unit&) const {}
    __device__ __forceinline__ void done(const Unit&) const {}
};

typedef float f32x2c_t __attribute__((ext_vector_type(2))); typedef __bf16 bf16x2c_t __attribute__((ext_vector_type(2)));
__device__ __forceinline__ unsigned cvt_pk_bf16(float lo, float hi) { f32x2c_t v = {lo, hi}; bf16x2c_t b = __builtin_convertvector(v, bf16x2c_t); return __builtin_bit_cast(unsigned, b); }
typedef float f32x2v __attribute__((ext_vector_type(2)));
__device__ __forceinline__ void st8(bf16_t* p, const float (&v)[8]) {
    u32x4 w; w.x = cvt_pk_bf16(v[0], v[1]); w.y = cvt_pk_bf16(v[2], v[3]); w.z = cvt_pk_bf16(v[4], v[5]); w.w = cvt_pk_bf16(v[6], v[7]); *(u32x4*)p = w;
}
__device__ __forceinline__ void ld8(const bf16_t* p, float (&v)[8]) {
    const u32x4 w = *(const u32x4*)p;
    v[0] = __uint_as_float(w.x << 16); v[1] = __uint_as_float(w.x & 0xffff0000u); v[2] = __uint_as_float(w.y << 16); v[3] = __uint_as_float(w.y & 0xffff0000u);
    v[4] = __uint_as_float(w.z << 16); v[5] = __uint_as_float(w.z & 0xffff0000u); v[6] = __uint_as_float(w.w << 16); v[7] = __uint_as_float(w.w & 0xffff0000u);
}
#define ACC8(dst, ai, bj, m) do { const f32x4 a0_ = acc[ai][bj][m][0], a1_ = acc[ai][bj][m][1]; dst[0] = a0_[0]; dst[1] = a0_[1]; dst[2] = a0_[2]; dst[3] = a0_[3]; dst[4] = a1_[0]; dst[5] = a1_[1]; dst[6] = a1_[2]; dst[7] = a1_[3]; } while (0)

struct Epi1 {
    static constexpr bool PERM = true, AFTER_DRAIN = false;
    bf16_t *QA, *QB, *GA; const float* gains; const float* T1; const float* T2;
    static constexpr size_t KA_OFF = (size_t)48 * 1048576 / 2, VA_OFF = (size_t)60 * 1048576 / 2, QKV_STRIDE = (size_t)72 * 1048576 / 2;
    __device__ __forceinline__ void operator()(const f32x4 (&acc)[2][2][4][2], const Unit& u, int wr, int wc, int fr, int fq) const {
        const int pn = u.pn, r0 = u.pm * BM;
        int seqbase, lgS; if (r0 < MPROMPT) { lgS = 12; seqbase = r0 & ~4095; } else { lgS = 11; seqbase = MPROMPT + ((r0 - MPROMPT) & ~2047); }
        if (pn >= 12) {
            bf16_t* G = GA + (pn < 16 ? (size_t)0 : (size_t)MTOK * 1024); const int cb = ((pn - 12) & 3) * 256 + wc * 32 + fq * 8;
#pragma unroll
            for (int ai = 0; ai < 2; ++ai)
#pragma unroll
                for (int m = 0; m < 4; ++m) { const size_t row = (size_t)(r0 + ai * HALF + wr * 64 + m * 16 + fr);
#pragma unroll
                    for (int bj = 0; bj < 2; ++bj) { float v[8]; ACC8(v, ai, bj, m);
#pragma unroll
                        for (int e = 0; e < 8; ++e) v[e] = __builtin_amdgcn_rcpf(1.0f + __builtin_amdgcn_exp2f(-1.4426950408889634f * v[e]));
                        st8(G + row * 1024 + cb + bj * HALF, v); } }
        } else if (pn >= 3) {
            const int kind = (pn - 3) / 3, g = (pn - 3) - 3 * kind, sh = 2 * g, lgL = lgS - sh;
            bf16_t* dst = QB + (size_t)kind * QKV_STRIDE + (size_t)g * MTOK * 256 + wc * 64 + fq * 8;
#pragma unroll
            for (int ai = 0; ai < 2; ++ai)
#pragma unroll
                for (int m = 0; m < 4; ++m) { const int row = r0 + ai * HALF + wr * 64 + m * 16 + fr, t = row - seqbase;
                    const size_t rowp = (size_t)(seqbase + ((t & ((1 << sh) - 1)) << lgL) + (t >> sh));
                    float v0[8], v1[8]; ACC8(v0, ai, 0, m); ACC8(v1, ai, 1, m);
                    if (kind < 2) {
                        const f32x4* tp = (const f32x4*)(T2 + (size_t)t * 16);
#pragma unroll
                        for (int k = 0; k < 4; ++k) { const f32x4 cs = tp[k];
                            { const float p = __shfl_xor(v0[2 * k], 16); const float o = v0[2 * k] * cs[0] + (fq == 0 ? -p : p) * cs[1]; v0[2 * k] = fq < 2 ? o : v0[2 * k]; }
                            { const float p = __shfl_xor(v0[2 * k + 1], 16); const float o = v0[2 * k + 1] * cs[2] + (fq == 0 ? -p : p) * cs[3]; v0[2 * k + 1] = fq < 2 ? o : v0[2 * k + 1]; } }
                        if (kind == 0) {
#pragma unroll
                            for (int e = 0; e < 8; ++e) { v0[e] *= QSCALE; v1[e] *= QSCALE; } }
                    }
                    st8(dst + rowp * 256, v0); st8(dst + rowp * 256 + 32, v1); }
        } else if (pn == 2 && wc >= 2) {
#pragma unroll
            for (int ai = 0; ai < 2; ++ai)
#pragma unroll
                for (int m = 0; m < 4; ++m) { const size_t row = (size_t)(r0 + ai * HALF + wr * 64 + m * 16 + fr);
#pragma unroll
                    for (int bj = 0; bj < 2; ++bj) { float v[8]; ACC8(v, ai, bj, m); st8(QA + VA_OFF + row * 128 + (wc - 2) * 64 + bj * 32 + fq * 8, v); } }
        } else {
            const bool isq = pn < 2; const float* gn = gains + (isq ? 0 : 64);
            float gv[2][8];
#pragma unroll
            for (int bj = 0; bj < 2; ++bj)
#pragma unroll
                for (int e = 0; e < 8; ++e) gv[bj][e] = gn[32 * bj + 8 * fq + e];
            bf16_t* dst = QA + (isq ? (size_t)((pn * 4 + wc) * 64) : KA_OFF + (size_t)(wc * 64)) + fq * 8; const int pitch = isq ? 512 : 128;
            const float osc = isq ? QSCALE : 1.0f;
#pragma unroll
            for (int ai = 0; ai < 2; ++ai)
#pragma unroll
                for (int m = 0; m < 4; ++m) { const int row = r0 + ai * HALF + wr * 64 + m * 16 + fr, t = row - seqbase;
                    float v[2][8]; ACC8(v[0], ai, 0, m); ACC8(v[1], ai, 1, m);
                    float ss = 0.f;
#pragma unroll
                    for (int bj = 0; bj < 2; ++bj)
#pragma unroll
                        for (int e = 0; e < 8; ++e) ss += v[bj][e] * v[bj][e];
                    ss += __shfl_xor(ss, 16); ss += __shfl_xor(ss, 32);
                    const float rinv = 1.0f / sqrtf(ss * (1.0f / 64.0f) + RMS_EPS);
#pragma unroll
                    for (int bj = 0; bj < 2; ++bj) { const int pos = bj == 0 ? (t >> 6) : (t & 63);
                        const f32x4* tp = (const f32x4*)(T1 + (size_t)pos * 32 + 16 * (fq & 1));
                        float o[8];
#pragma unroll
                        for (int k = 0; k < 4; ++k) { const f32x4 cs = tp[k];
                            { const float y = v[bj][2 * k] * rinv * gv[bj][2 * k]; const float p = __shfl_xor(y, 32); o[2 * k] = (y * cs[0] + (fq < 2 ? -p : p) * cs[1]) * osc; }
                            { const float y = v[bj][2 * k + 1] * rinv * gv[bj][2 * k + 1]; const float p = __shfl_xor(y, 32); o[2 * k + 1] = (y * cs[2] + (fq < 2 ? -p : p) * cs[3]) * osc; } }
                        st8(dst + (size_t)row * pitch + bj * 32, o); } }
        }
    }
};
struct Epi3a {
    static constexpr bool PERM = true, AFTER_DRAIN = false; const bf16_t* GA; bf16_t* MIX;
    __device__ __forceinline__ void operator()(const f32x4 (&acc)[2][2][4][2], const Unit& u, int wr, int wc, int fr, int fq) const {
        const int col0 = u.pn * BM + wc * 32 + fq * 8;
#pragma unroll
        for (int ai = 0; ai < 2; ++ai)
#pragma unroll
            for (int m = 0; m < 4; ++m) { const size_t row = (size_t)(u.pm * BM + ai * HALF + wr * 64 + m * 16 + fr);
#pragma unroll
                for (int bj = 0; bj < 2; ++bj) { float v[8], gq[8]; ACC8(v, ai, bj, m); ld8(GA + row * 1024 + col0 + bj * HALF, gq);
#pragma unroll
                    for (int e = 0; e < 8; ++e) v[e] *= gq[e];
                    st8(MIX + row * 1024 + col0 + bj * HALF, v); } }
    }
};
struct Epi3b {
    static constexpr bool PERM = true, AFTER_DRAIN = false; const bf16_t* GB; bf16_t* MIX;
    __device__ __forceinline__ void operator()(const f32x4 (&acc)[2][2][4][2], const Unit& u, int wr, int wc, int fr, int fq) const {
        const int col0 = u.pn * BM + wc * 32 + fq * 8;
#pragma unroll
        for (int ai = 0; ai < 2; ++ai)
#pragma unroll
            for (int m = 0; m < 4; ++m) { const size_t row = (size_t)(u.pm * BM + ai * HALF + wr * 64 + m * 16 + fr);
#pragma unroll
                for (int bj = 0; bj < 2; ++bj) { float v[8], gq[8], mx[8]; ACC8(v, ai, bj, m); ld8(GB + row * 1024 + col0 + bj * HALF, gq); ld8(MIX + row * 1024 + col0 + bj * HALF, mx);
#pragma unroll
                    for (int e = 0; e < 8; ++e) v[e] = mx[e] + v[e] * gq[e];
                    st8(MIX + row * 1024 + col0 + bj * HALF, v); } }
    }
};
struct Epi4 {
    static constexpr bool PERM = true, AFTER_DRAIN = false; const float* XP; long long xs_delta; float* X1; bf16_t* H2; const float* gm; float* SS;
    __device__ __forceinline__ void operator()(const f32x4 (&acc)[2][2][4][2], const Unit& u, int wr, int wc, int fr, int fq) const {
        const int col0 = u.pn * BM + wc * 32 + fq * 8, r0 = u.pm * BM;
        const float* X = (const float*)((const char*)XP + (r0 < MPROMPT ? 0ll : xs_delta)) + (size_t)r0 * 1024;
        float gv[2][8];
#pragma unroll
        for (int bj = 0; bj < 2; ++bj)
#pragma unroll
            for (int e = 0; e < 8; ++e) gv[bj][e] = gm[col0 + bj * HALF + e];
#pragma unroll
        for (int ai = 0; ai < 2; ++ai)
#pragma unroll
            for (int m = 0; m < 4; ++m) { const int rl = ai * HALF + wr * 64 + m * 16 + fr; const size_t row = (size_t)(r0 + rl); float ss = 0.f;
#pragma unroll
                for (int bj = 0; bj < 2; ++bj) { const float* xp = X + (size_t)rl * 1024 + col0 + bj * HALF; const f32x4 x0 = *(const f32x4*)xp, x1v = *(const f32x4*)(xp + 4);
                    const f32x4 y0 = x0 + acc[ai][bj][m][0], y1 = x1v + acc[ai][bj][m][1];
                    float* op = X1 + row * 1024 + col0 + bj * HALF; *(f32x4*)op = y0; *(f32x4*)(op + 4) = y1;
                    ss += (y0[0] * y0[0] + y0[1] * y0[1]) + (y0[2] * y0[2] + y0[3] * y0[3]) + (y1[0] * y1[0] + y1[1] * y1[1]) + (y1[2] * y1[2] + y1[3] * y1[3]);
                    float h[8] = {y0[0] * gv[bj][0], y0[1] * gv[bj][1], y0[2] * gv[bj][2], y0[3] * gv[bj][3], y1[0] * gv[bj][4], y1[1] * gv[bj][5], y1[2] * gv[bj][6], y1[3] * gv[bj][7]};
                    st8(H2 + row * 1024 + col0 + bj * HALF, h); }
                ss += __shfl_xor(ss, 16); ss += __shfl_xor(ss, 32);
                if (fq == 0) SS[row * 16 + u.pn * 4 + wc] = ss; }
    }
};
struct Epi5 {
    static constexpr bool PERM = true, AFTER_DRAIN = false; bf16_t* U; const float* SS;
    __device__ __forceinline__ void operator()(const f32x4 (&acc)[2][2][4][2], const Unit& u, int wr, int wc, int fr, int fq) const {
        const int col0 = u.pn * BM + wc * 32 + fq * 8;
#pragma unroll
        for (int ai = 0; ai < 2; ++ai)
#pragma unroll
            for (int m = 0; m < 4; ++m) { const size_t row = (size_t)(u.pm * BM + ai * HALF + wr * 64 + m * 16 + fr);
                const f32x4* sp = (const f32x4*)(SS + row * 16); const f32x4 s0 = sp[0], s1 = sp[1], s2 = sp[2], s3 = sp[3];
                const f32x4 sv = (s0 + s1) + (s2 + s3); const float tot = (sv[0] + sv[1]) + (sv[2] + sv[3]);
                const float r2 = 1.0f / (tot * (1.0f / 1024.0f) + RMS_EPS);
#pragma unroll
                for (int bj = 0; bj < 2; ++bj) { float v[8]; ACC8(v, ai, bj, m);
#pragma unroll
                    for (int e = 0; e < 8; ++e) { const float a = fmaxf(v[e], 0.f); v[e] = a * a * r2; }
                    st8(U + row * 4096 + col0 + bj * HALF, v); } }
    }
};
struct Epi6 {
    static constexpr bool PERM = true, AFTER_DRAIN = false; float* Y; float* SS;
    __device__ __forceinline__ void operator()(const f32x4 (&acc)[2][2][4][2], const Unit& u, int wr, int wc, int fr, int fq) const {
        const int col0 = u.pn * BM + wc * 32 + fq * 8;
#pragma unroll
        for (int ai = 0; ai < 2; ++ai)
#pragma unroll
            for (int m = 0; m < 4; ++m) { const size_t row = (size_t)(u.pm * BM + ai * HALF + wr * 64 + m * 16 + fr); float ss = 0.f;
#pragma unroll
                for (int bj = 0; bj < 2; ++bj) { float* op = Y + row * 1024 + col0 + bj * HALF; const f32x4 x0 = *(const f32x4*)op, x1v = *(const f32x4*)(op + 4);
                    const f32x4 y0 = x0 + acc[ai][bj][m][0], y1 = x1v + acc[ai][bj][m][1];
                    *(f32x4*)op = y0; *(f32x4*)(op + 4) = y1;
                    ss += (y0[0] * y0[0] + y0[1] * y0[1]) + (y0[2] * y0[2] + y0[3] * y0[3]) + (y1[0] * y1[0] + y1[1] * y1[1]) + (y1[2] * y1[2] + y1[3] * y1[3]); }
                ss += __shfl_xor(ss, 16); ss += __shfl_xor(ss, 32);
                if (fq == 0) SS[row * 16 + u.pn * 4 + wc] = ss; }
    }
};
#undef ACC8
template <class Epi, class Sched, bool ALIGN_EPI = false, bool SP2 = false>
__device__ __forceinline__ void gemm_phase(PG8_LAS unsigned char* lds, const Gemm g, const Sched& S, const Epi& E) {
    int tid_l = threadIdx.x; asm volatile("" : "+v"(tid_l));
    const int tid = tid_l, wid = __builtin_amdgcn_readfirstlane(tid >> 6), lane = tid & 63, wr = wid >> 2, wc = wid & 3, fr = lane & 15, fq = lane >> 4;
    const int K = g.K, nt = K / BK;
    unsigned voffA[2], voffB[2];
#pragma unroll
    for (int i = 0; i < 2; ++i) { int R, C; stage_rc(tid * 16 + i * 8192, R, C); const int Rb = Epi::PERM ? ((R & ~31) + perm32(R & 31)) : R;
        voffA[i] = (unsigned)(R * K + C) * 2u; voffB[i] = (unsigned)(Rb * K + C) * 2u; }
    const size_t kstep = (size_t)(BK * 2);
    const size_t hstep = (size_t)HALF * K * 2;
    const size_t tstep = 2 * hstep;
    const unsigned ldsw = (unsigned)wid * 1024u;
    const int aoff = lds_byte(wr * 64 + fr, fq * 8), boff = lds_byte(wc * 32 + fr, fq * 8);
#define PG8_SA(b, h) (((b) * 2 + (h)) * HTB)
#define PG8_SB(b, h) ((4 + (b) * 2 + (h)) * HTB)
#define PG8_STAGE(bufoff, gbase, voff) do { _Pragma("unroll") for (int _i = 0; _i < 2; ++_i) \
        __builtin_amdgcn_global_load_lds((const unsigned*)((const char*)(gbase) + (voff)[_i]), (PG8_LAS unsigned*)(lds + (bufoff) + ldsw + _i * 8192), 16, 0, 0); } while (0)
#define PG8_LDA(dst, b, h) do { _Pragma("unroll") for (int m = 0; m < 4; ++m) _Pragma("unroll") for (int k = 0; k < 2; ++k) dst[m][k] = *(const PG8_LAS bf16x8*)(lds + PG8_SA(b, h) + aoff + m * 2048 + k * 1024); } while (0)
#define PG8_LDB(dst, b, h) do { _Pragma("unroll") for (int n = 0; n < 2; ++n) _Pragma("unroll") for (int k = 0; k < 2; ++k) dst[n][k] = *(const PG8_LAS bf16x8*)(lds + PG8_SB(b, h) + boff + n * 2048 + k * 1024); } while (0)
#define PG8_MMA(ai, bj, At, Bt) do { __builtin_amdgcn_s_setprio(1); _Pragma("unroll") for (int m = 0; m < 4; ++m) _Pragma("unroll") for (int n = 0; n < 2; ++n) _Pragma("unroll") for (int k = 0; k < 2; ++k) \
        acc[ai][bj][m][n] = __builtin_amdgcn_mfma_f32_16x16x32_bf16(Bt[n][k], At[m][k], acc[ai][bj][m][n], 0, 0, 0); __builtin_amdgcn_s_setprio(0); } while (0)
#define PG8_WAIT_V(n) asm volatile("s_waitcnt vmcnt(" #n ")" ::: "memory")
#define PG8_WAIT_L(n) asm volatile("s_waitcnt lgkmcnt(" #n ")" ::: "memory")
#define PG8_BAR __builtin_amdgcn_s_barrier()
#define PG8_SCHED __builtin_amdgcn_sched_barrier(0)
    Unit cur, nxt; int ui = 0;
    if (!S.next(0, cur)) return;
    f32x4 acc[2][2][4][2];
#pragma unroll
    for (int a = 0; a < 2; ++a)
#pragma unroll
        for (int b = 0; b < 2; ++b)
#pragma unroll
            for (int m = 0; m < 4; ++m)
#pragma unroll
                for (int n = 0; n < 2; ++n) acc[a][b][m][n] = (f32x4){0.f, 0.f, 0.f, 0.f};
    bf16x8 At[4][2], B0[2][2], B1[2][2];
    const char* cA = (const char*)g.A + (size_t)cur.pm * tstep; const char* cB = (const char*)g.Bt + (size_t)cur.pn * tstep;
    S.a_ready(cur);
    if constexpr (SP2) {
        PG8_STAGE(PG8_SB(0, 0), cB, voffB); PG8_STAGE(PG8_SB(0, 1), cB + hstep, voffB); PG8_STAGE(PG8_SA(0, 0), cA, voffA); PG8_STAGE(PG8_SA(0, 1), cA + hstep, voffA);
        if (wr == 1) PG8_BAR;
        PG8_WAIT_V(2); PG8_BAR;
        PG8_STAGE(PG8_SB(1, 0), cB + kstep, voffB); PG8_STAGE(PG8_SA(1, 0), cA + kstep, voffA); PG8_STAGE(PG8_SB(1, 1), cB + hstep + kstep, voffB);
        PG8_WAIT_V(6); PG8_BAR;
    } else {
        PG8_STAGE(PG8_SB(0, 0), cB, voffB); PG8_STAGE(PG8_SA(0, 0), cA, voffA); PG8_STAGE(PG8_SB(0, 1), cB + hstep, voffB); PG8_STAGE(PG8_SA(0, 1), cA + hstep, voffA);
        if (wr == 1) PG8_BAR;
        PG8_WAIT_V(4); PG8_BAR;
        PG8_STAGE(PG8_SB(1, 0), cB + kstep, voffB); PG8_STAGE(PG8_SA(1, 0), cA + kstep, voffA); PG8_STAGE(PG8_SB(1, 1), cB + hstep + kstep, voffB);
        PG8_WAIT_V(6); PG8_BAR;
    }
    for (;;) {
        const bool has_next = S.next(ui + 1, nxt);
        const char* nA = has_next ? (const char*)g.A + (size_t)nxt.pm * tstep : cA; const char* nB = has_next ? (const char*)g.Bt + (size_t)nxt.pn * tstep : cB;
        for (int t = 0; t < nt; t += 2) {
            const bool last = (t == nt - 2);
            const char* a1 = cA + (size_t)(t + 1) * kstep;
            const char* a2 = last ? nA : cA + (size_t)(t + 2) * kstep; const char* b2 = last ? nB : cB + (size_t)(t + 2) * kstep;
            const char* a3 = a2 + kstep; const char* b3 = b2 + kstep;
            if (last && has_next) S.a_ready(nxt);
            if constexpr (SP2) {
            PG8_LDB(B0, 0, 0); PG8_LDB(B1, 0, 1); PG8_SCHED; PG8_LDA(At, 0, 0); PG8_STAGE(PG8_SA(1, 1), a1 + hstep, voffA);
            PG8_WAIT_V(8); PG8_WAIT_L(0); PG8_BAR; PG8_MMA(0, 0, At, B0); PG8_MMA(0, 1, At, B1); PG8_BAR; PG8_SCHED;
            PG8_LDA(At, 0, 1); PG8_STAGE(PG8_SB(0, 0), b2, voffB); PG8_STAGE(PG8_SB(0, 1), b2 + hstep, voffB); PG8_STAGE(PG8_SA(0, 0), a2, voffA);
            PG8_WAIT_V(8); PG8_WAIT_L(0); PG8_BAR; PG8_MMA(1, 0, At, B0); PG8_MMA(1, 1, At, B1); PG8_BAR; PG8_SCHED;
            PG8_LDB(B0, 1, 0); PG8_LDB(B1, 1, 1); PG8_SCHED; PG8_LDA(At, 1, 0); PG8_STAGE(PG8_SA(0, 1), a2 + hstep, voffA);
            PG8_WAIT_V(8); PG8_WAIT_L(0); PG8_BAR; PG8_MMA(0, 0, At, B0); PG8_MMA(0, 1, At, B1); PG8_BAR; PG8_SCHED;
            PG8_LDA(At, 1, 1); PG8_STAGE(PG8_SB(1, 0), b3, voffB); PG8_STAGE(PG8_SB(1, 1), b3 + hstep, voffB); PG8_STAGE(PG8_SA(1, 0), a3, voffA);
            PG8_WAIT_V(8); PG8_WAIT_L(0); PG8_BAR; PG8_MMA(1, 0, At, B0); PG8_MMA(1, 1, At, B1); PG8_BAR; PG8_SCHED;
            } else {
            PG8_LDB(B0, 0, 0); PG8_SCHED; PG8_LDA(At, 0, 0); PG8_STAGE(PG8_SA(1, 1), a1 + hstep, voffA);
            PG8_WAIT_L(8); PG8_BAR; PG8_WAIT_L(0); PG8_MMA(0, 0, At, B0); PG8_BAR; PG8_SCHED;
            PG8_LDB(B1, 0, 1); PG8_STAGE(PG8_SB(0, 0), b2, voffB);
            PG8_BAR; PG8_WAIT_L(0); PG8_MMA(0, 1, At, B1); PG8_BAR;
            PG8_LDA(At, 0, 1); PG8_STAGE(PG8_SA(0, 0), a2, voffA);
            PG8_BAR; PG8_WAIT_L(0); PG8_MMA(1, 0, At, B0); PG8_BAR; PG8_SCHED;
            PG8_STAGE(PG8_SB(0, 1), b2 + hstep, voffB);
            PG8_WAIT_V(6); PG8_BAR; PG8_MMA(1, 1, At, B1); PG8_BAR;
            PG8_LDB(B0, 1, 0); PG8_SCHED; PG8_LDA(At, 1, 0); PG8_STAGE(PG8_SA(0, 1), a2 + hstep, voffA);
            PG8_WAIT_L(8); PG8_BAR; PG8_WAIT_L(0); PG8_MMA(0, 0, At, B0); PG8_BAR; PG8_SCHED;
            PG8_LDB(B1, 1, 1); PG8_STAGE(PG8_SB(1, 0), b3, voffB);
            PG8_BAR; PG8_WAIT_L(0); PG8_MMA(0, 1, At, B1); PG8_BAR;
            PG8_LDA(At, 1, 1); PG8_STAGE(PG8_SA(1, 0), a3, voffA);
            PG8_BAR; PG8_WAIT_L(0); PG8_MMA(1, 0, At, B0); PG8_BAR; PG8_SCHED;
            PG8_STAGE(PG8_SB(1, 1), b3 + hstep, voffB);
            PG8_WAIT_V(6); PG8_BAR; PG8_MMA(1, 1, At, B1); PG8_BAR;
            }
        }
        if constexpr (ALIGN_EPI) { if (wr == 0) PG8_BAR; }
        if constexpr (!Epi::AFTER_DRAIN) { E(acc, cur, wr, wc, fr, fq); S.done(cur); }
        if (!has_next) break;
#pragma unroll
        for (int a = 0; a < 2; ++a)
#pragma unroll
            for (int b = 0; b < 2; ++b)
#pragma unroll
                for (int m = 0; m < 4; ++m)
#pragma unroll
                    for (int n = 0; n < 2; ++n) acc[a][b][m][n] = (f32x4){0.f, 0.f, 0.f, 0.f};
        cur = nxt; cA = nA; cB = nB; ++ui;
        if constexpr (ALIGN_EPI) { if (wr == 1) PG8_BAR; }
    }
    PG8_WAIT_V(0);
    if constexpr (!ALIGN_EPI) { if (wr == 0) PG8_BAR; }
    PG8_BAR;
    if constexpr (Epi::AFTER_DRAIN) { E.fused(acc, cur, wr, wc, fr, fq, lds, wid, lane); S.done(cur); }
#undef PG8_SA
#undef PG8_SB
#undef PG8_STAGE
#undef PG8_LDA
#undef PG8_LDB
#undef PG8_MMA
#undef PG8_WAIT_V
#undef PG8_WAIT_L
#undef PG8_BAR
#undef PG8_SCHED
}
}
#include <hip/hip_bf16.h>
namespace attn_body {
using bf16=__hip_bfloat16;
using bf16x8=__attribute__((ext_vector_type(8)))short;
using s16x4=__attribute__((ext_vector_type(4)))short;
using f32x16=__attribute__((ext_vector_type(16)))float;
using u32x4=__attribute__((ext_vector_type(4)))unsigned;
constexpr int D=64,QP=512,KP=128,VP=128,OP=512;
constexpr int NW=8,QBLK=32,QB=QBLK*NW,KVBLK=64;
constexpr int ATTN_UNIT_ROWS=QB;
__device__ __forceinline__ int crow(int r,int hi){return (r&3)+8*(r>>2)+4*hi;}
#define SBAR() __builtin_amdgcn_sched_barrier(0)
__device__ __forceinline__ void cmask(f32x16&p0,f32x16&p1,int jb,int qrel,int hi){
  const float NEG=-INFINITY; int kb=64*jb+4*hi;
  #pragma unroll
  for(int r=0;r<16;++r){int kv=kb+(r&3)+8*(r>>2); if(kv>qrel)p0[r]=NEG; if(kv+32>qrel)p1[r]=NEG;}
}

constexpr int NSLOT=3, SLOTB=8192;
constexpr int LDS_K=0, LDS_V=NSLOT*SLOTB, LDS_WS=2*NSLOT*SLOTB, LDS_OST=LDS_WS+NW*64*4, LDS_BYTES=LDS_OST+NW*4096;
constexpr float C2=0.125f*1.4426950408889634f;
__device__ __forceinline__ void glds16(const void*gsrc,unsigned lds_dst){unsigned keep;
  asm volatile("s_mov_b32 %0, m0\n\ts_mov_b32 m0, %2\n\ts_nop 0\n\tglobal_load_lds_dwordx4 %1, off\n\ts_mov_b32 m0, %0":"=&s"(keep):"v"(gsrc),"s"(lds_dst):"memory");}
__device__ __forceinline__ float max3f(float a,float b,float c){float r;asm("v_max3_f32 %0, %1, %2, %3":"=v"(r):"v"(a),"v"(b),"v"(c));return r;}
__device__ __forceinline__ float max2f(float a,float b){float r;asm("v_max_f32_e32 %0, %1, %2":"=v"(r):"v"(a),"v"(b));return r;}
__device__ __forceinline__ float fadd_s(float a,float b){float r;asm("v_add_f32_e32 %0, %1, %2":"=v"(r):"v"(a),"v"(b));return r;}
__device__ __forceinline__ float fsub_s(float a,float b){float r;asm("v_sub_f32_e32 %0, %1, %2":"=v"(r):"v"(a),"v"(b));return r;}
typedef float f32x2_t __attribute__((ext_vector_type(2))); typedef __bf16 bf16x2_t __attribute__((ext_vector_type(2)));
__device__ __forceinline__ unsigned cvtpk_s(float lo,float hi){f32x2_t v={lo,hi};bf16x2_t b=__builtin_convertvector(v,bf16x2_t);return __builtin_bit_cast(unsigned,b);}
#define WAIT_BAR(N) asm volatile("s_waitcnt vmcnt(" #N ") lgkmcnt(0)\n\ts_barrier":::"memory")

__device__ __forceinline__ void qkt(f32x16&p0,f32x16&p1,const char*Kslot,const bf16x8*qr,const f32x16&negm,int r32,int hi){
  const char*kb=Kslot+hi*1024+r32*16;
  #pragma unroll
  for(int d0=0;d0<4;++d0){
    const bf16x8 b0=*reinterpret_cast<const bf16x8*>(kb+d0*2048);
    const bf16x8 b1=*reinterpret_cast<const bf16x8*>(kb+d0*2048+512);
    if(d0==0){p0=__builtin_amdgcn_mfma_f32_32x32x16_bf16(b0,qr[0],negm,0,0,0);p1=__builtin_amdgcn_mfma_f32_32x32x16_bf16(b1,qr[0],negm,0,0,0);}
    else{p0=__builtin_amdgcn_mfma_f32_32x32x16_bf16(b0,qr[d0],p0,0,0,0);p1=__builtin_amdgcn_mfma_f32_32x32x16_bf16(b1,qr[d0],p1,0,0,0);}}
}
typedef __attribute__((address_space(3))) const char* lds_cptr;
typedef short v4i16_t __attribute__((ext_vector_type(4)));
__device__ __forceinline__ void kload8(bf16x8*kf,lds_cptr kp){
  kf[0]=*(const __attribute__((address_space(3))) bf16x8*)(kp);      kf[1]=*(const __attribute__((address_space(3))) bf16x8*)(kp+512);
  kf[2]=*(const __attribute__((address_space(3))) bf16x8*)(kp+2048); kf[3]=*(const __attribute__((address_space(3))) bf16x8*)(kp+2560);
  kf[4]=*(const __attribute__((address_space(3))) bf16x8*)(kp+4096); kf[5]=*(const __attribute__((address_space(3))) bf16x8*)(kp+4608);
  kf[6]=*(const __attribute__((address_space(3))) bf16x8*)(kp+6144); kf[7]=*(const __attribute__((address_space(3))) bf16x8*)(kp+6656);
}
__device__ __forceinline__ void kload2(bf16x8*kf,lds_cptr kp,int j){ kf[2*j]=*(const __attribute__((address_space(3))) bf16x8*)(kp+j*2048); kf[2*j+1]=*(const __attribute__((address_space(3))) bf16x8*)(kp+j*2048+512); }
__device__ __forceinline__ s16x4 vtr(lds_cptr p){ return __builtin_bit_cast(s16x4,__builtin_amdgcn_ds_read_tr16_b64_v4i16((__attribute__((address_space(3))) v4i16_t*)p)); }
__device__ __forceinline__ float rowmax(const f32x16&p0,const f32x16&p1){
  float a=max3f(p0[0],p0[1],p1[0]),b=max3f(p0[2],p0[3],p1[1]);a=max3f(a,p1[2],p1[3]);
  #pragma unroll
  for(int r=4;r<16;r+=4){a=max3f(a,p0[r],p0[r+1]);b=max3f(b,p0[r+2],p0[r+3]);a=max3f(a,p1[r],p1[r+1]);b=max3f(b,p1[r+2],p1[r+3]);}
  const float m=max2f(a,b);
  auto rr=__builtin_amdgcn_permlane32_swap(__float_as_uint(m),__float_as_uint(m),false,false);
  return max2f(__uint_as_float(rr[0]),__uint_as_float(rr[1]));
}
__device__ __forceinline__ void pv(f32x16*o,int vb,bf16x8 pa0,bf16x8 pa1,bf16x8 pa2,bf16x8 pa3){
  #pragma unroll
  for(int d0=0;d0<2;++d0){s16x4 lo[4],hi[4];
    #pragma unroll
    for(int ks=0;ks<4;++ks){
      asm volatile("ds_read_b64_tr_b16 %0,%1 offset:%c2":"=&v"(lo[ks]):"v"(vb),"i"(d0*4096+ks*1024):"memory");
      asm volatile("ds_read_b64_tr_b16 %0,%1 offset:%c2":"=&v"(hi[ks]):"v"(vb),"i"(d0*4096+ks*1024+512):"memory");}
    asm volatile("s_waitcnt lgkmcnt(0)":::"memory");SBAR();
    #define PK(k) (bf16x8){lo[k][0],lo[k][1],lo[k][2],lo[k][3],hi[k][0],hi[k][1],hi[k][2],hi[k][3]}
    o[d0]=__builtin_amdgcn_mfma_f32_32x32x16_bf16(pa0,PK(0),o[d0],0,0,0);
    o[d0]=__builtin_amdgcn_mfma_f32_32x32x16_bf16(pa1,PK(1),o[d0],0,0,0);
    o[d0]=__builtin_amdgcn_mfma_f32_32x32x16_bf16(pa2,PK(2),o[d0],0,0,0);
    o[d0]=__builtin_amdgcn_mfma_f32_32x32x16_bf16(pa3,PK(3),o[d0],0,0,0);
    #undef PK
  }
}

#ifndef ATTN_STORE16
#define ATTN_STORE16(p,v) (*(u32x4*)(p)=(v))
#endif
template<int THRL> __device__ __forceinline__ void attn_unit(const bf16*Qu,const bf16*__restrict__ Kh,const bf16*__restrict__ Vh,bf16*Ou,const int NT,char*shm){
  int tid_l=threadIdx.x; asm volatile("":"+v"(tid_l)); const int tid=tid_l,lane=tid&63,r32=lane&31,hi=lane>>5; const int wid=__builtin_amdgcn_readfirstlane(tid>>6);
  const bf16*Qw=Qu+(long)(wid*QBLK)*QP;
  const unsigned lds0=(unsigned)(uintptr_t)shm;
  float*wsf=(float*)(shm+LDS_WS)+wid*64;
  const bf16*ksrc=Kh+(long)lane*KP+wid*8;
  const bf16*vsrc=Vh+(long)(16*(wid&3)+(lane>>2))*VP+(wid>>2)*32+(lane&3)*8;
  const unsigned kdst=lds0+LDS_K+wid*1024, vdst=lds0+LDS_V+wid*1024;
  #define DMA_K(t,slot) glds16(ksrc+(long)(t)*KVBLK*KP,(unsigned)__builtin_amdgcn_readfirstlane(kdst+(slot)))
  #define DMA_V(t,slot) glds16(vsrc+(long)(t)*KVBLK*VP,(unsigned)__builtin_amdgcn_readfirstlane(vdst+(slot)))
  const int vb0=(int)(lds0+LDS_V)+((lane>>4)&1)*32+(lane&3)*8+(4*hi+((lane&15)>>2))*64;
  const char*Kbase=shm+LDS_K; bf16x8 kf[8];
  const lds_cptr shm3=(lds_cptr)shm; const lds_cptr kp0=shm3+LDS_K+hi*1024+r32*16; const lds_cptr vp0=shm3+LDS_V+((lane>>4)&1)*32+(lane&3)*8+(4*hi+((lane&15)>>2))*64;
  DMA_K(0,0);DMA_V(0,0);DMA_K(1,SLOTB);
  bf16x8 qr[4];
  #pragma unroll
  for(int d0=0;d0<4;++d0)qr[d0]=*reinterpret_cast<const bf16x8*>(&Qw[(long)r32*QP+d0*16+hi*8]);
  float mhat=0.f,l_reg=0.f;f32x16 o[2];o[0]=f32x16{};o[1]=f32x16{};f32x16 negm=f32x16{};asm volatile("":"+v"(negm));
  #define CMASK(P0,P1,t) do{}while(0)
  bool resc=false;
  #define START(P0,P1) do{ const float rm=rowmax(P0,P1); resc=false; \
    { const float dl=rm; mhat=fadd_s(mhat,dl); \
      _Pragma("unroll") for(int r=0;r<16;++r){P0[r]=fsub_s(P0[r],dl);P1[r]=fsub_s(P1[r],dl);} \
      _Pragma("unroll") for(int r=0;r<16;++r)negm[r]=-mhat; asm volatile("":"+v"(negm)); } \
    _Pragma("unroll") for(int r=0;r<16;++r)P0[r]=__builtin_amdgcn_exp2f(P0[r]); }while(0)
  #define RESC() do{ if(resc){ asm volatile("s_waitcnt lgkmcnt(0)":::"memory"); \
      _Pragma("unroll") for(int d_=0;d_<2;++d_) _Pragma("unroll") for(int r=0;r<16;++r)o[d_][r]*=wsf[crow(r,hi)]; } }while(0)
  f32x16 pA0,pA1,pB0,pB1;
  int sl_prev=0,sl_cur=0,sl_next=SLOTB;
  #define ROT() do{sl_prev=sl_cur;sl_cur=sl_next;sl_next=(sl_next==(NSLOT-1)*SLOTB)?0:sl_next+SLOTB;}while(0)
  DMA_K(2,2*SLOTB);
  WAIT_BAR(3);
  qkt(pA0,pA1,Kbase,qr,negm,r32,hi);asm volatile("s_nop 15\n\ts_nop 7":"+v"(pA0),"+v"(pA1));CMASK(pA0,pA1,0);
  START(pA0,pA1);
  _Pragma("unroll") for(int r=0;r<16;++r)pA1[r]=__builtin_amdgcn_exp2f(pA1[r]);
  WAIT_BAR(0);
  DMA_K(3,0);DMA_V(1,SLOTB);
  ROT();
  kload8(kf,kp0+sl_cur);
  WAIT_BAR(2);
  s16x4 vlo[8],vhi[8]; u32x4 pw0,pw1,pw2,pw3;
  #define PKW(P,B) cvtpk_s(P[B],P[B+1])
  #define PAF(k) __builtin_bit_cast(bf16x8,pw##k)
  #define VFR(i) (bf16x8){vlo[i][0],vlo[i][1],vlo[i][2],vlo[i][3],vhi[i][0],vhi[i][1],vhi[i][2],vhi[i][3]}
  #define PIN(x) asm volatile("":"+v"(x))
  #define MX3(a,b,c) __builtin_fmaxf(__builtin_fmaxf((a),(b)),(c))
  #define GAPA(MF,A0,A1,A2,A3,W0,W1,PW) do{ MF; sacc+=A0; sacc+=A1; sacc+=A2; sacc+=A3; PIN(sacc); W0; W1; PIN(PW); SBAR(); }while(0)
  #define EX(v) __builtin_amdgcn_exp2f(v)
  #define GAPB(MF,X,B) do{ MF; X[B]=EX(X[B]); X[B+1]=EX(X[B+1]); X[B+2]=EX(X[B+2]); X[B+3]=EX(X[B+3]); PIN(X); SBAR(); }while(0)
  #define VRD(i) do{ vlo[i]=vtr(vp_+(((i)>>2)*4096+((i)&3)*1024)); vhi[i]=vtr(vp_+(((i)>>2)*4096+((i)&3)*1024+512)); }while(0)
  #define KRD(G,j) do{ if(G){ kload2(kf,kp0+sl_next,j); SBAR(); } }while(0)
  #define STEP(C0,C1,P0,P1,t,GK,GV,GL) do{ SBAR(); \
    const lds_cptr vp_=vp0+sl_prev; \
    VRD(0); SBAR(); float sacc=(P0[0]+P0[1]); \
    GAPA(C0=__builtin_amdgcn_mfma_f32_32x32x16_bf16(kf[0],qr[0],negm,0,0,0), P0[2],P0[3],P0[4],P0[5],     pw0[0]=PKW(P0,0), pw0[1]=PKW(P0,2), pw0); \
    VRD(4); SBAR(); GAPA(C1=__builtin_amdgcn_mfma_f32_32x32x16_bf16(kf[1],qr[0],negm,0,0,0), P0[6],P0[7],P0[8],P0[9],     pw0[2]=PKW(P0,4), pw0[3]=PKW(P0,6), pw0); \
    VRD(1); SBAR(); GAPA(C0=__builtin_amdgcn_mfma_f32_32x32x16_bf16(kf[2],qr[1],C0,0,0,0),   P0[10],P0[11],P0[12],P0[13], pw1[0]=PKW(P0,8), pw1[1]=PKW(P0,10), pw1); \
    VRD(5); SBAR(); GAPA(C1=__builtin_amdgcn_mfma_f32_32x32x16_bf16(kf[3],qr[1],C1,0,0,0),   P0[14],P0[15],P1[0],P1[1],   pw1[2]=PKW(P0,12),pw1[3]=PKW(P0,14), pw1); \
    VRD(2); SBAR(); GAPA(C0=__builtin_amdgcn_mfma_f32_32x32x16_bf16(kf[4],qr[2],C0,0,0,0),   P1[2],P1[3],P1[4],P1[5],     pw2[0]=PKW(P1,0), pw2[1]=PKW(P1,2), pw2); \
    VRD(6); SBAR(); GAPA(C1=__builtin_amdgcn_mfma_f32_32x32x16_bf16(kf[5],qr[2],C1,0,0,0),   P1[6],P1[7],P1[8],P1[9],     pw2[2]=PKW(P1,4), pw2[3]=PKW(P1,6), pw2); \
    VRD(3); SBAR(); GAPA(C0=__builtin_amdgcn_mfma_f32_32x32x16_bf16(kf[6],qr[3],C0,0,0,0),   P1[10],P1[11],P1[12],P1[13], pw3[0]=PKW(P1,8), pw3[1]=PKW(P1,10), pw3); \
    VRD(7); SBAR(); GAPA(C1=__builtin_amdgcn_mfma_f32_32x32x16_bf16(kf[7],qr[3],C1,0,0,0),   P1[14],P1[15],0.f,0.f,       pw3[2]=PKW(P1,12),pw3[3]=PKW(P1,14), pw3); \
    l_reg+=sacc; \
    if(GK){DMA_K((t)+3,sl_cur);} if(GV){DMA_V((t)+1,sl_next);} \
    CMASK(C0,C1,t); \
    { float a=MX3(C0[0],C0[1],C1[0]),b=MX3(C0[2],C0[3],C1[1]); a=MX3(a,C1[2],C1[3]); \
      _Pragma("unroll") for(int r=4;r<16;r+=4){a=MX3(a,C0[r],C0[r+1]);b=MX3(b,C0[r+2],C0[r+3]);a=MX3(a,C1[r],C1[r+1]);b=MX3(b,C1[r+2],C1[r+3]);} \
      float rm=__builtin_fmaxf(a,b); { auto rr=__builtin_amdgcn_permlane32_swap(__float_as_uint(rm),__float_as_uint(rm),false,false); rm=__builtin_fmaxf(__uint_as_float(rr[0]),__uint_as_float(rr[1])); } \
      resc=false; \
      if(__builtin_expect(__any(rm>(float)THRL),0)){ const float dl=__builtin_fmaxf(rm,0.f); mhat+=dl; \
        _Pragma("unroll") for(int r=0;r<16;++r){C0[r]-=dl;C1[r]-=dl;} \
        _Pragma("unroll") for(int r=0;r<16;++r)negm[r]=-mhat; asm volatile("":"+v"(negm)); \
        const float f=__builtin_amdgcn_exp2f(-dl); l_reg*=f; if(hi==0)wsf[r32]=f; resc=true; } } \
    SBAR(); \
    GAPB(o[0]=__builtin_amdgcn_mfma_f32_32x32x16_bf16(PAF(0),VFR(0),o[0],0,0,0), C0,0); \
    GAPB(o[1]=__builtin_amdgcn_mfma_f32_32x32x16_bf16(PAF(0),VFR(4),o[1],0,0,0), C0,4); \
    KRD(GL,0); GAPB(o[0]=__builtin_amdgcn_mfma_f32_32x32x16_bf16(PAF(1),VFR(1),o[0],0,0,0), C0,8); \
    KRD(GL,1); GAPB(o[1]=__builtin_amdgcn_mfma_f32_32x32x16_bf16(PAF(1),VFR(5),o[1],0,0,0), C0,12); \
    KRD(GL,2); GAPB(o[0]=__builtin_amdgcn_mfma_f32_32x32x16_bf16(PAF(2),VFR(2),o[0],0,0,0), C1,0); \
    KRD(GL,3); GAPB(o[1]=__builtin_amdgcn_mfma_f32_32x32x16_bf16(PAF(2),VFR(6),o[1],0,0,0), C1,4); \
    GAPB(o[0]=__builtin_amdgcn_mfma_f32_32x32x16_bf16(PAF(3),VFR(3),o[0],0,0,0), C1,8); \
    GAPB(o[1]=__builtin_amdgcn_mfma_f32_32x32x16_bf16(PAF(3),VFR(7),o[1],0,0,0), C1,12); \
    }while(0)
  int t=1;
  #undef CMASK
  #define CMASK(P0,P1,t) do{}while(0)
  for(;t+5<NT;t+=2){
    STEP(pB0,pB1,pA0,pA1,t,true,true,true);     WAIT_BAR(2); RESC(); ROT();
    STEP(pA0,pA1,pB0,pB1,t+1,true,true,true);   WAIT_BAR(2); RESC(); ROT();
  }
  #undef CMASK
  #define CMASK(P0,P1,t) do{}while(0)
  #define ENDW(tt) do{ if((tt)+3<NT){WAIT_BAR(2);} else if((tt)+2<NT){WAIT_BAR(1);} else {WAIT_BAR(0);} }while(0)
  for(;t+1<NT;t+=2){
    STEP(pB0,pB1,pA0,pA1,t,(t+3<NT),(t+1<NT),(t+1<NT));       ENDW(t);   RESC(); ROT();
    STEP(pA0,pA1,pB0,pB1,t+1,(t+4<NT),(t+2<NT),(t+2<NT));     ENDW(t+1); RESC(); ROT();
  }
  STEP(pB0,pB1,pA0,pA1,NT-1,false,false,false); RESC();
  { float sacc=pB0[0]+pB0[1]; _Pragma("unroll") for(int r=2;r<16;++r)sacc+=pB0[r]; _Pragma("unroll") for(int r=0;r<16;++r)sacc+=pB1[r]; l_reg+=sacc;
    pw0=(u32x4){PKW(pB0,0),PKW(pB0,2),PKW(pB0,4),PKW(pB0,6)};pw1=(u32x4){PKW(pB0,8),PKW(pB0,10),PKW(pB0,12),PKW(pB0,14)};pw2=(u32x4){PKW(pB1,0),PKW(pB1,2),PKW(pB1,4),PKW(pB1,6)};pw3=(u32x4){PKW(pB1,8),PKW(pB1,10),PKW(pB1,12),PKW(pB1,14)};
    SBAR(); pv(o,vb0+sl_cur,PAF(0),PAF(1),PAF(2),PAF(3)); }
  #undef PKW
  #undef PAF
  #undef VFR
  #undef PIN
  #undef MX3
  #undef GAPA
  #undef GAPB
  #undef EX
  #undef VRD
  #undef KRD
  #undef STEP
  #undef ENDW
  {auto rr=__builtin_amdgcn_permlane32_swap(__float_as_uint(l_reg),__float_as_uint(l_reg),false,false);l_reg=__uint_as_float(rr[0])+__uint_as_float(rr[1]);}
  if(hi==0)wsf[32+r32]=l_reg;asm volatile("s_waitcnt lgkmcnt(0)":::"memory");
  float rli[16];
  #pragma unroll
  for(int r=0;r<16;++r)rli[r]=__builtin_amdgcn_rcpf(wsf[32+crow(r,hi)]);
  bf16*Ow=Ou+(long)(wid*QBLK)*OP;
  { bf16*stg=(bf16*)(shm+LDS_OST)+wid*2048;
    #pragma unroll
    for(int r=0;r<16;++r){const int orow=crow(r,hi);
      #pragma unroll
      for(int d0=0;d0<2;++d0)stg[orow*64+d0*32+r32]=__float2bfloat16(o[d0][r]*rli[r]);}
    asm volatile("s_waitcnt lgkmcnt(0)":::"memory");
    #pragma unroll
    for(int i=0;i<4;++i){const int row=i*8+(lane>>3),ch=lane&7; const u32x4 v=*(const u32x4*)(stg+row*64+ch*8); ATTN_STORE16(Ow+(long)row*OP+ch*8,v);} }
  asm volatile("s_waitcnt lgkmcnt(0)\n\ts_barrier":::"memory");
  #undef DMA_K
  #undef DMA_V
  #undef CMASK
  #undef START
  #undef RESC
  #undef ROT
}
constexpr int ATTN_LDS_BYTES=LDS_BYTES;
#undef SBAR
#undef WAIT_BAR
}
namespace dil {
using bf16x8 = __attribute__((ext_vector_type(8))) short;
using s16x4 = __attribute__((ext_vector_type(4))) short;
using f32x16 = __attribute__((ext_vector_type(16))) float;
using u32x4 = __attribute__((ext_vector_type(4))) unsigned;
typedef unsigned short bf16_t;
#define DLAS __attribute__((address_space(3)))
constexpr int VPITCH = 144, VBUF = 32 * VPITCH, WAVE_LDS = 2 * VBUF;
__device__ __forceinline__ int crow(int r, int hi) { return (r & 3) + 8 * (r >> 2) + 4 * hi; }
typedef float f32x2c_t __attribute__((ext_vector_type(2))); typedef __bf16 bf16x2c_t __attribute__((ext_vector_type(2)));
__device__ __forceinline__ unsigned cvtpk(float lo, float hi) { f32x2c_t v = {lo, hi}; bf16x2c_t b = __builtin_convertvector(v, bf16x2c_t); return __builtin_bit_cast(unsigned, b); }
__device__ __forceinline__ void dil_task(int task, const bf16_t* __restrict__ QB, const bf16_t* __restrict__ KB, const bf16_t* __restrict__ VB, bf16_t* OBP, float* LSE, DLAS char* vbuf, int lane) {
    const int r32 = lane & 31, hi = lane >> 5;
    const int h = task & 3, rbg = task >> 2, g = rbg / 1536, rb = rbg - g * 1536, sh = 2 * g, rowp0 = rb * 32;
    int seqbase, lgS; if (rowp0 < MPROMPT) { lgS = 12; seqbase = rowp0 & ~4095; } else { lgS = 11; seqbase = MPROMPT + ((rowp0 - MPROMPT) & ~2047); }
    const int lgL = lgS - sh, L = 1 << lgL, tl = rowp0 - seqbase, rho = tl >> lgL, u0 = tl & (L - 1), segbase = rowp0 - u0;
    const size_t goff = (size_t)g * MTOK * 256;
    const bf16_t* Qp = QB + goff + (size_t)(rowp0 + r32) * 256 + h * 64 + hi * 8;
    bf16x8 qf[4];
#pragma unroll
    for (int d0 = 0; d0 < 4; ++d0) qf[d0] = *(const bf16x8*)(Qp + d0 * 16);
    f32x16 p[5];
#pragma unroll
    for (int j = 0; j < 5; ++j) { int uu = u0 - 64 + 32 * j + r32; uu = uu < 0 ? 0 : (uu > L - 1 ? L - 1 : uu);
        const bf16_t* Kp = KB + goff + (size_t)(segbase + uu) * 256 + h * 64 + hi * 8;
        f32x16 a = f32x16{};
#pragma unroll
        for (int d0 = 0; d0 < 4; ++d0) a = __builtin_amdgcn_mfma_f32_32x32x16_bf16(*(const bf16x8*)(Kp + d0 * 16), qf[d0], a, 0, 0, 0);
        p[j] = a; }
#define DIL_VLOAD(dst, j) do { _Pragma("unroll") for (int i = 0; i < 4; ++i) { const int c = lane + 64 * i, kk = c >> 3, ch = c & 7; int uu = u0 - 64 + 32 * (j) + kk; uu = uu < 0 ? 0 : (uu > L - 1 ? L - 1 : uu); \
        dst[i] = *(const u32x4*)(VB + goff + (size_t)(segbase + uu) * 256 + h * 64 + ch * 8); } } while (0)
    u32x4 vreg[2][4];
    DIL_VLOAD(vreg[0], 0); DIL_VLOAD(vreg[1], 1);
    float mx = -INFINITY;
#pragma unroll
    for (int j = 0; j < 5; ++j)
#pragma unroll
        for (int r = 0; r < 16; ++r) { const int rel = 32 * j - 64 + crow(r, hi) - r32, uk = u0 + r32 + rel;
            const bool valid = (rel >= -64) && (rel <= 64) && (uk >= 0) && (uk < L);
            const float s = valid ? p[j][r] : -INFINITY; p[j][r] = s; mx = fmaxf(mx, s); }
    mx = fmaxf(mx, __shfl_xor(mx, 32));
    float l = 0.f;
#pragma unroll
    for (int j = 0; j < 5; ++j)
#pragma unroll
        for (int r = 0; r < 16; ++r) { const float e = __builtin_amdgcn_exp2f(p[j][r] - mx); p[j][r] = e; l += e; }
    l += __shfl_xor(l, 32);
    f32x16 o[2]; o[0] = f32x16{}; o[1] = f32x16{};
    const unsigned vb0 = (unsigned)(uintptr_t)vbuf + (unsigned)((4 * hi + ((lane & 15) >> 2)) * VPITCH + ((lane >> 4) & 1) * 32 + (lane & 3) * 8);
#pragma unroll
    for (int j = 0; j < 5; ++j) { DLAS char* buf = vbuf + (j & 1) * VBUF; const unsigned vb = vb0 + (unsigned)((j & 1) * VBUF);
#pragma unroll
        for (int i = 0; i < 4; ++i) { const int c = lane + 64 * i, kk = c >> 3, ch = c & 7; *(DLAS u32x4*)(buf + kk * VPITCH + ch * 16) = vreg[j & 1][i]; }
        if (j + 2 < 5) DIL_VLOAD(vreg[j & 1], j + 2);
        asm volatile("s_waitcnt lgkmcnt(0)" ::: "memory");
        s16x4 lo[2][2], hh[2][2];
#pragma unroll
        for (int ks = 0; ks < 2; ++ks)
#pragma unroll
            for (int db = 0; db < 2; ++db) {
                asm volatile("ds_read_b64_tr_b16 %0, %1 offset:%c2" : "=&v"(lo[ks][db]) : "v"(vb), "i"(ks * 16 * VPITCH + db * 64) : "memory");
                asm volatile("ds_read_b64_tr_b16 %0, %1 offset:%c2" : "=&v"(hh[ks][db]) : "v"(vb), "i"(ks * 16 * VPITCH + db * 64 + 8 * VPITCH) : "memory"); }
        asm volatile("s_waitcnt lgkmcnt(0)" ::: "memory"); __builtin_amdgcn_sched_barrier(0);
#pragma unroll
        for (int ks = 0; ks < 2; ++ks) { u32x4 pw; pw.x = cvtpk(p[j][8 * ks + 0], p[j][8 * ks + 1]); pw.y = cvtpk(p[j][8 * ks + 2], p[j][8 * ks + 3]); pw.z = cvtpk(p[j][8 * ks + 4], p[j][8 * ks + 5]); pw.w = cvtpk(p[j][8 * ks + 6], p[j][8 * ks + 7]);
            const bf16x8 pa = __builtin_bit_cast(bf16x8, pw);
#pragma unroll
            for (int db = 0; db < 2; ++db) { const bf16x8 vf = (bf16x8){lo[ks][db][0], lo[ks][db][1], lo[ks][db][2], lo[ks][db][3], hh[ks][db][0], hh[ks][db][1], hh[ks][db][2], hh[ks][db][3]};
                o[db] = __builtin_amdgcn_mfma_f32_32x32x16_bf16(pa, vf, o[db], 0, 0, 0); } }
    }
    const float linv = 1.0f / l, lse2 = mx + __builtin_amdgcn_logf(l);
#pragma unroll
    for (int r = 0; r < 16; ++r) { const int q = crow(r, hi); const float rl = __shfl(linv, q); const size_t row = (size_t)(seqbase + rho + ((u0 + q) << sh));
        bf16_t* op = OBP + goff + row * 256 + h * 64 + r32;
        op[0] = (bf16_t)(cvtpk(o[0][r] * rl, 0.f) & 0xffffu); op[32] = (bf16_t)(cvtpk(o[1][r] * rl, 0.f) & 0xffffu); }
    if (hi == 0) LSE[((size_t)g * MTOK + (size_t)(seqbase + rho + ((u0 + r32) << sh))) * 4 + h] = lse2;
}
#undef DIL_VLOAD
}

constexpr size_t MiB = 1u << 20;
constexpr size_t WS_GN = 1 * MiB - 4096, WS_T1 = 1 * MiB, WS_T2 = 1 * MiB + 65536, WS_SS1 = 2 * MiB, WS_SS2 = 5 * MiB, WS_LSE = 8 * MiB;
constexpr size_t WS_WUP = 12 * MiB, WS_WDN = 20 * MiB;
constexpr size_t WS_U = 28 * MiB, WS_H2 = 412 * MiB, WS_END = 508 * MiB;
constexpr size_t WS_W1 = 28 * MiB, WS_WA = 38 * MiB, WS_WB = 39 * MiB, WS_WO = 40 * MiB;
constexpr size_t WS_H1 = 44 * MiB, WS_OBP = 44 * MiB, WS_OB = 116 * MiB;
constexpr size_t WS_QA = 140 * MiB, WS_KA = 188 * MiB, WS_VA = 200 * MiB, WS_QB = 212 * MiB, WS_KB = 284 * MiB, WS_VB = 356 * MiB, WS_OA = 428 * MiB;
constexpr size_t WS_MIX = 212 * MiB;
constexpr int LDS_BYTES = 147456, NWAVES = 8;
#define LAS __attribute__((address_space(3)))
typedef unsigned short bf16;
typedef unsigned v4u __attribute__((ext_vector_type(4)));
typedef float f32x4 __attribute__((ext_vector_type(4)));
__device__ __forceinline__ unsigned f2bf(float f) { unsigned u = __builtin_bit_cast(unsigned, f); return (u + 0x7fffu + ((u >> 16) & 1u)) >> 16; }
__device__ __forceinline__ unsigned pk2(float lo, float hi) { return f2bf(lo) | (f2bf(hi) << 16); }
__device__ __forceinline__ float wave_sum(float v) {
#pragma unroll
    for (int o = 1; o < 64; o <<= 1) v += __shfl_xor(v, o);
    return v;
}
__device__ __forceinline__ void p0_transpose_item(const float* W, int K, int N, bf16* WT, int k0, int n0, int orow0, LAS float* scr, int lane) {
#pragma unroll 8
    for (int i = 0; i < 32; ++i) { const int kk = 2 * i + (lane >> 5); scr[kk * 33 + (lane & 31)] = W[(size_t)(k0 + kk) * N + n0 + (lane & 31)]; }
    asm volatile("s_waitcnt lgkmcnt(0)" ::: "memory");
    const int c = lane & 7;
#pragma unroll
    for (int j = 0; j < 4; ++j) { const int n = (lane >> 3) + 8 * j; const LAS float* s = scr + (8 * c) * 33 + n;
        v4u o; o.x = pk2(s[0 * 33], s[1 * 33]); o.y = pk2(s[2 * 33], s[3 * 33]); o.z = pk2(s[4 * 33], s[5 * 33]); o.w = pk2(s[6 * 33], s[7 * 33]);
        *(v4u*)(WT + (size_t)(orow0 + n) * K + k0 + 8 * c) = o; }
    asm volatile("s_waitcnt lgkmcnt(0)" ::: "memory");
}
__device__ __forceinline__ void transpose_matrix(const float* W, int K, int N, bf16* WT, bool perm, LAS float* scr, int lane, int gw, int NGW) {
    const int nblk = N / 32, nitems = (K / 64) * nblk;
    for (int it = gw; it < nitems; it += NGW) { const int kb = it / nblk, nb = it - kb * nblk, n0 = 32 * nb; int orow0 = n0;
        if (perm && n0 < 3072) { const int nl = n0 & 255; orow0 = (n0 & ~255) + 128 * ((nl >> 5) & 1) + 32 * (nl >> 6); }
        p0_transpose_item(W, K, N, WT, 64 * kb, n0, orow0, scr, lane); }
}

#define XB_TMO      128
#define XB_XCNT(j)  (256  + 64 * (j))
#define XB_XSUB(j)  (1280 + 64 * (j))
#define XB_XGEN(j)  (2304 + 64 * (j))
#define XB_TOP      3328
#define XB_TOPGEN   3392
#define XCD_BAR_WORDS 3456
#define XB_SPIN_CAP (1u << 18)

__device__ __forceinline__ unsigned xb_ld(unsigned* p)              { return __hip_atomic_load(p, __ATOMIC_RELAXED, __HIP_MEMORY_SCOPE_AGENT); }
__device__ __forceinline__ unsigned xb_add(unsigned* p, unsigned v) { return __hip_atomic_fetch_add(p, v, __ATOMIC_RELAXED, __HIP_MEMORY_SCOPE_AGENT); }
__device__ __forceinline__ unsigned xb_xcc_id() { return (unsigned)__builtin_amdgcn_s_getreg((3 << 11) | 20) & 0xFu; }
#define XB_SPIN(cond, bar) do { unsigned _sp = 0; while (cond) { __builtin_amdgcn_s_sleep(1); \
    if ((++_sp & 255u) == 0u) { if (xb_ld(&(bar)[XB_TMO])) break; if (_sp > XB_SPIN_CAP) { atomicAdd(&(bar)[XB_TMO], 1u); break; } } } } while (0)

struct XcdBarrier {
    unsigned* bar; unsigned x;
    volatile LAS unsigned* st;
};

__device__ __forceinline__ XcdBarrier xcd_barrier_post(unsigned* bar, volatile LAS unsigned* st) {
    XcdBarrier b; b.bar = bar; b.x = xb_xcc_id(); b.st = st;
    if (threadIdx.x == 0) (void)xb_add(&bar[XB_XCNT(b.x)], 1u);
    return b;
}
__device__ __forceinline__ void xcd_barrier_complete(unsigned* bar, unsigned x, unsigned& nloc, unsigned& nx) {
    const unsigned G = gridDim.x * gridDim.y * gridDim.z;
    unsigned sum, cnt, mine, sp = 0u;
    for (;;) {
        sum = 0u; cnt = 0u; mine = 0u;
#pragma unroll
        for (unsigned j = 0; j < 16; ++j) { const unsigned c = xb_ld(&bar[XB_XCNT(j)]); sum += c; cnt += (c > 0u) ? 1u : 0u; mine = (j == x) ? c : mine; }
        if (sum == G) break;
        __builtin_amdgcn_s_sleep(1);
        if ((++sp & 255u) == 0u) { if (xb_ld(&bar[XB_TMO])) break; if (sp > XB_SPIN_CAP) { atomicAdd(&bar[XB_TMO], 1u); break; } }
    }
    nloc = mine > 0u ? mine : 1u; nx = cnt > 0u ? cnt : 1u;
}

__device__ __forceinline__ void xcd_barrier(const XcdBarrier& b) {
    asm volatile("s_waitcnt vmcnt(0)" ::: "memory");
    __syncthreads();
    if (threadIdx.x == 0) {
        unsigned* bar = b.bar;
        __builtin_amdgcn_s_waitcnt(0);
        unsigned nloc = b.st[0], nx = b.st[1];
        if (nloc == 0u) { xcd_barrier_complete(bar, b.x, nloc, nx); b.st[0] = nloc; b.st[1] = nx; }
        const unsigned old = xb_add(&bar[XB_XSUB(b.x)], 1u);
        const unsigned gen = old / nloc;
        if (old + 1u == (gen + 1u) * nloc) {
            __builtin_amdgcn_fence(__ATOMIC_RELEASE, "agent");
            asm volatile("s_waitcnt vmcnt(0)" ::: "memory");
            const unsigned og = xb_add(&bar[XB_TOP], 1u);
            const unsigned tg = og / nx;
            if (og + 1u == (tg + 1u) * nx) xb_add(&bar[XB_TOPGEN], 1u);
            else XB_SPIN(xb_ld(&bar[XB_TOPGEN]) == tg, bar);
            __builtin_amdgcn_fence(__ATOMIC_ACQUIRE, "agent");
            xb_add(&bar[XB_XGEN(b.x)], 1u);
            asm volatile("s_waitcnt vmcnt(0)" ::: "memory");
        } else {
            XB_SPIN(xb_ld(&bar[XB_XGEN(b.x)]) == gen, bar);
            __builtin_amdgcn_fence(__ATOMIC_ACQUIRE, "agent");
            asm volatile("s_waitcnt vmcnt(0)" ::: "memory");
        }
    }
    __syncthreads();
}

struct Args { const float* in[13]; float* out; unsigned char* ws; };
__global__ void __launch_bounds__(NWAVES * 64, 2) fwd_megakernel(Args args) {
    extern __shared__ __attribute__((aligned(16))) unsigned char lds[];
    cg::grid_group grid = cg::this_grid();
    LAS unsigned char* ldsl = (LAS unsigned char*)lds;
#define GEOM() int tid_l = threadIdx.x; asm volatile("" : "+v"(tid_l)); const int tid = tid_l, lane = tid & 63, wave = __builtin_amdgcn_readfirstlane(tid >> 6); (void)lane; const int G = gridDim.x, bx = blockIdx.x, vcu = (G % 8 == 0) ? (bx % 8) * (G / 8) + bx / 8 : bx, gw = vcu * NWAVES + wave, NGW = G * NWAVES; (void)vcu; (void)gw; (void)NGW
#define WSP(T, off) ((T*)(args.ws + (off)))
#define GRID_SYNC() xcd_barrier(xbar)
    { volatile LAS unsigned* misc_ = (volatile LAS unsigned*)(ldsl + 139264); if (threadIdx.x < 16) misc_[threadIdx.x] = 0u; }
    __syncthreads();
    const XcdBarrier xbar = xcd_barrier_post((unsigned*)args.ws, (volatile LAS unsigned*)(ldsl + 139264));
    grid.sync();

    {
        GEOM();
        LAS float* scr = (LAS float*)(ldsl + wave * 16384);
        transpose_matrix(args.in[2], 1024, 5120, WSP(bf16, WS_W1), true, scr, lane, gw, NGW);
        transpose_matrix(args.in[3], 512, 1024, WSP(bf16, WS_WA), false, scr, lane, gw, NGW);
        transpose_matrix(args.in[4], 256, 1024, WSP(bf16, WS_WB), false, scr, lane, gw, NGW);
        transpose_matrix(args.in[5], 1024, 1024, WSP(bf16, WS_WO), false, scr, lane, gw, NGW);
        transpose_matrix(args.in[10], 1024, 4096, WSP(bf16, WS_WUP), false, scr, lane, gw, NGW);
        transpose_matrix(args.in[11], 4096, 1024, WSP(bf16, WS_WDN), false, scr, lane, gw, NGW);
        float* T1 = WSP(float, WS_T1); float* T2 = WSP(float, WS_T2); float* GN = WSP(float, WS_GN);
        const int gt = bx * (NWAVES * 64) + tid, NT_ = G * NWAVES * 64;
        for (int i = gt; i < 64 * 16 + 4096 * 8 + 128; i += NT_) {
            if (i < 1024) { const int pos = i >> 4, k = i & 15; const float fr = (float)pow(10000.0, -(double)k / 16.0); const float ang = (float)pos * fr;
                T1[2 * i] = (float)cos((double)ang); T1[2 * i + 1] = (float)sin((double)ang); }
            else if (i < 1024 + 32768) { const int j = i - 1024, pos = j >> 3, k = j & 7; const float fr = (float)pow(500000.0, -(double)k / 8.0); const float ang = (float)pos * fr;
                T2[2 * j] = (float)cos((double)ang); T2[2 * j + 1] = (float)sin((double)ang); }
            else { const int j = i - 1024 - 32768; GN[j] = j < 64 ? args.in[7][j] : args.in[8][j - 64]; }
        }
        const float *xp = args.in[0], *xs = args.in[1], *g_mix = args.in[6]; bf16* H1 = WSP(bf16, WS_H1);
        for (int m = gw; m < MTOK; m += NGW) {
            const float* xrow = m < MPROMPT ? xp + (size_t)m * 1024 : xs + (size_t)(m - MPROMPT) * 1024;
            const f32x4* xr = (const f32x4*)xrow + lane; const f32x4* gr = (const f32x4*)g_mix + lane;
            f32x4 v[4]; float s = 0.f;
#pragma unroll
            for (int j = 0; j < 4; ++j) { v[j] = xr[64 * j]; s += (v[j].x * v[j].x + v[j].y * v[j].y) + (v[j].z * v[j].z + v[j].w * v[j].w); }
            const float rinv = 1.0f / sqrtf(wave_sum(s) * (1.0f / 1024.0f) + RMS_EPS);
            unsigned long long* o8 = (unsigned long long*)(H1 + (size_t)m * 1024) + lane;
#pragma unroll
            for (int j = 0; j < 4; ++j) { const f32x4 gq = gr[64 * j]; o8[64 * j] = (unsigned long long)pk2(v[j].x * rinv * gq.x, v[j].y * rinv * gq.y) | ((unsigned long long)pk2(v[j].z * rinv * gq.z, v[j].w * rinv * gq.w) << 32); }
        }
    }
    GRID_SYNC();
    {
        GEOM();
        pg8::Gemm g{WSP(bf16, WS_H1), WSP(bf16, WS_W1), MTOK, 5120, 1024}; pg8::StaticOrder S; S.init(MTOK, 5120, G, bx);
        pg8::Epi1 E{WSP(bf16, WS_QA), WSP(bf16, WS_QB), (bf16*)args.out, WSP(float, WS_GN), WSP(float, WS_T1), WSP(float, WS_T2)};
        pg8::gemm_phase<pg8::Epi1, pg8::StaticOrder, true, true>(ldsl, g, S, E);
    }
    GRID_SYNC();
    {
        GEOM();
        LAS char* vbuf = (LAS char*)ldsl + wave * dil::WAVE_LDS;
        for (int task = gw; task < 3 * 1536 * 4; task += NGW) dil::dil_task(task, WSP(bf16, WS_QB), WSP(bf16, WS_KB), WSP(bf16, WS_VB), WSP(bf16, WS_OBP), WSP(float, WS_LSE), vbuf, lane);
    }
    GRID_SYNC();
    {
        GEOM();
        {
        const float* LSE = WSP(float, WS_LSE); const bf16* OBP = WSP(bf16, WS_OBP); bf16* OB = WSP(bf16, WS_OB);
        const int gt = bx * (NWAVES * 64) + tid, NT_ = G * NWAVES * 64;
        for (int idx = gt; idx < MTOK * 32; idx += NT_) { const int row = idx >> 5, ch = idx & 31, h = ch >> 3;
            const float l0 = LSE[((size_t)row) * 4 + h], l1 = LSE[((size_t)MTOK + row) * 4 + h], l2 = LSE[((size_t)2 * MTOK + row) * 4 + h];
            const float mx = fmaxf(l0, fmaxf(l1, l2)); float w0 = __builtin_amdgcn_exp2f(l0 - mx), w1 = __builtin_amdgcn_exp2f(l1 - mx), w2 = __builtin_amdgcn_exp2f(l2 - mx);
            const float inv = 1.0f / (w0 + w1 + w2); w0 *= inv; w1 *= inv; w2 *= inv;
            float a[8], b[8], c[8], o[8]; pg8::ld8(OBP + (size_t)row * 256 + ch * 8, a); pg8::ld8(OBP + ((size_t)MTOK + row) * 256 + ch * 8, b); pg8::ld8(OBP + ((size_t)2 * MTOK + row) * 256 + ch * 8, c);
#pragma unroll
            for (int e = 0; e < 8; ++e) o[e] = w0 * a[e] + w1 * b[e] + w2 * c[e];
            pg8::st8(OB + (size_t)row * 256 + ch * 8, o); }
        }
        __syncthreads();
        const attn_body::bf16* QA = WSP(const attn_body::bf16, WS_QA); const attn_body::bf16* KA = WSP(const attn_body::bf16, WS_KA); const attn_body::bf16* VA = WSP(const attn_body::bf16, WS_VA); attn_body::bf16* OA = WSP(attn_body::bf16, WS_OA);
        for (int vv = vcu; vv < 256; vv += G) {
            for (int i = 0; i < 6; ++i) {
                int b, h, qb, nt; size_t rb;
                if (i < 2) { const int id = 2 * vv + i; b = id >> 7; h = (id >> 4) & 7; qb = id & 15; rb = (size_t)b * 4096; nt = 64; }
                else { const int id = 4 * vv + (i - 2); b = id >> 6; h = (id >> 3) & 7; qb = id & 7; rb = (size_t)MPROMPT + (size_t)b * 2048; nt = 32; }
                attn_body::attn_unit<8>(QA + (rb + qb * 256) * 512 + h * 64, KA + rb * 128 + (h >> 2) * 64, VA + rb * 128 + (h >> 2) * 64, OA + (rb + qb * 256) * 512 + h * 64, nt, (char*)lds);
            }
        }
    }
    GRID_SYNC();
    {
        GEOM();
        pg8::Gemm g{WSP(bf16, WS_OA), WSP(bf16, WS_WA), MTOK, 1024, 512}; pg8::StaticOrder S; S.init(MTOK, 1024, G, bx);
        pg8::Epi3a E{(const bf16*)args.out, WSP(bf16, WS_MIX)};
        pg8::gemm_phase<pg8::Epi3a, pg8::StaticOrder, true, true>(ldsl, g, S, E);
    }
    __syncthreads();
    {
        GEOM();
        pg8::Gemm g{WSP(bf16, WS_OB), WSP(bf16, WS_WB), MTOK, 1024, 256}; pg8::StaticOrder S; S.init(MTOK, 1024, G, bx);
        pg8::Epi3b E{(const bf16*)args.out + (size_t)MTOK * 1024, WSP(bf16, WS_MIX)};
        pg8::gemm_phase<pg8::Epi3b, pg8::StaticOrder, true, true>(ldsl, g, S, E);
    }
    GRID_SYNC();
    {
        GEOM();
        pg8::Gemm g{WSP(bf16, WS_MIX), WSP(bf16, WS_WO), MTOK, 1024, 1024}; pg8::StaticOrder S; S.init(MTOK, 1024, G, bx);
        pg8::Epi4 E{args.in[0], (long long)((const char*)args.in[1] - (const char*)args.in[0]) - (long long)MPROMPT * 4096, args.out, WSP(bf16, WS_H2), args.in[9], WSP(float, WS_SS1)};
        pg8::gemm_phase<pg8::Epi4, pg8::StaticOrder, true, true>(ldsl, g, S, E);
    }
    GRID_SYNC();
    {
        GEOM();
        pg8::Gemm g{WSP(bf16, WS_H2), WSP(bf16, WS_WUP), MTOK, 4096, 1024}; pg8::StaticOrder S; S.init(MTOK, 4096, G, bx);
        pg8::Epi5 E{WSP(bf16, WS_U), WSP(float, WS_SS1)};
        pg8::gemm_phase<pg8::Epi5, pg8::StaticOrder, true, true>(ldsl, g, S, E);
    }
    GRID_SYNC();
    {
        GEOM();
        pg8::Gemm g{WSP(bf16, WS_U), WSP(bf16, WS_WDN), MTOK, 1024, 4096}; pg8::StaticOrder S; S.init(MTOK, 1024, G, bx);
        pg8::Epi6 E{args.out, WSP(float, WS_SS2)};
        pg8::gemm_phase<pg8::Epi6, pg8::StaticOrder, true, true>(ldsl, g, S, E);
    }
    GRID_SYNC();
    {
        GEOM();
        float* out = args.out; const float* SS2 = WSP(float, WS_SS2); const float* g_fin = args.in[12];
        for (int m = gw; m < MTOK; m += NGW) {
            f32x4* xr = (f32x4*)(out + (size_t)m * 1024) + lane; const f32x4* gr = (const f32x4*)g_fin + lane;
            float s = lane < 16 ? SS2[(size_t)m * 16 + lane] : 0.f;
            const float rinv = 1.0f / sqrtf(wave_sum(s) * (1.0f / 1024.0f) + RMS_EPS);
#pragma unroll
            for (int j = 0; j < 4; ++j) { const f32x4 v = xr[64 * j], gq = gr[64 * j]; xr[64 * j] = v * rinv * gq; }
        }
    }
}

extern "C" void kernel_launch(void* const* d_in, const int* in_sizes, int n_in, void* d_out, int out_size, void* d_ws, size_t ws_size, hipStream_t stream) {
    static int grid = 0;
    if (grid == 0) {
        if (n_in != 13 || out_size != MTOK * 1024 || ws_size < WS_END) { fprintf(stderr, "kernel_launch: unexpected shapes (n_in %d, out %d, ws %zu)\n", n_in, out_size, ws_size); grid = -1; return; }
        int dev = 0, cus = 0, per_cu = 0;
        (void)hipGetDevice(&dev); (void)hipDeviceGetAttribute(&cus, hipDeviceAttributeMultiprocessorCount, dev);
        if (hipFuncSetAttribute((const void*)fwd_megakernel, hipFuncAttributeMaxDynamicSharedMemorySize, LDS_BYTES) != hipSuccess) { fprintf(stderr, "kernel_launch: hipFuncSetAttribute failed\n"); grid = -1; return; }
        if (hipOccupancyMaxActiveBlocksPerMultiprocessor(&per_cu, (const void*)fwd_megakernel, NWAVES * 64, LDS_BYTES) != hipSuccess || per_cu < 1) { fprintf(stderr, "kernel_launch: occupancy query says %d blocks per CU\n", per_cu); (void)hipGetLastError(); grid = -1; return; }
        grid = cus;
        if (grid > 256) grid = 256;
    }
    if (grid < 0) return;
    (void)hipMemsetAsync(d_ws, 0, 16384, stream);
    Args a{};
    for (int i = 0; i < 13; ++i) a.in[i] = (const float*)d_in[i];
    a.out = (float*)d_out; a.ws = (unsigned char*)d_ws;
    void* kargs[] = {&a};
    hipError_t e = hipLaunchCooperativeKernel((const void*)fwd_megakernel, dim3(grid), dim3(NWAVES * 64), kargs, LDS_BYTES, stream);
    if (e != hipSuccess) fprintf(stderr, "kernel_launch: cooperative launch failed: %s (grid %d)\n", hipGetErrorString(e), grid);
}
```
